# Optimizing an MI355X kernel written in HIP

```python
import jax, jax.numpy as jnp
from jax import lax
import numpy as np

D_MODEL = 1024
BATCH = 8
SEQ = 2048
DEPTH = 4
DEC_BATCH = 128
DEC_SEQ = 4
PAST_LEN = 16384
PAGE_SIZE = 128

N_MIXERS = 2
N_POOL = (DEPTH + 1) // 2
N_DN = DEPTH // 2
POOL_WINDOWS = (2, 4, 8, 16)
N_POOL_GROUPS = len(POOL_WINDOWS)
POOL_GROUP = D_MODEL // N_POOL_GROUPS
POOL_MAX = max(POOL_WINDOWS)
DK = 128
DV = 128
HK = D_MODEL // 128
HV = 2 * HK
KEY_DIM = HK * DK
VAL_DIM = HV * DV
CONV_W = 4
CONV_DIM = 2 * KEY_DIM + VAL_DIM
IN_DIM = CONV_DIM + VAL_DIM + 2 * HV
CHUNK = 64
D_FF = 2816
EPS = 1e-6

kernel_name = 'hybrid_pool_deltanet_macaron_step'


def rmsnorm(x, g):
    xf = x.astype(jnp.float32)
    y = xf * lax.rsqrt(jnp.mean(xf * xf, axis=-1, keepdims=True) + EPS) * g.astype(jnp.float32)
    return y.astype(x.dtype)


def l2norm(x):
    return x * lax.rsqrt(jnp.sum(x * x, axis=-1, keepdims=True) + EPS)


def swiglu(h, w_gate, w_up, w_down):
    return (jax.nn.silu(h @ w_gate) * (h @ w_up)) @ w_down


def pool_mixer(h, past, pos0, w_group, scale):
    B, S, D = h.shape
    P = POOL_MAX - 1
    hp = jnp.concatenate([past.astype(h.dtype), h], axis=1)
    cs = jnp.cumsum(hp.astype(jnp.float32), axis=1)
    cs = jnp.pad(cs, ((0, 0), (1, 0), (0, 0)))
    pos = pos0 + jnp.arange(S)
    groups = []
    for gi, w in enumerate(POOL_WINDOWS):
        lo, hi = gi * POOL_GROUP, (gi + 1) * POOL_GROUP
        win = cs[:, P + 1:P + 1 + S, lo:hi] - cs[:, P + 1 - w:P + 1 - w + S, lo:hi]
        cnt = jnp.minimum(pos + 1, w).astype(jnp.float32)[None, :, None]
        groups.append(win / cnt)
    pooled = jnp.concatenate(groups, axis=-1) - h.astype(jnp.float32)
    pooled = pooled.reshape(B, S, N_POOL_GROUPS, POOL_GROUP)
    y = jnp.einsum('bsgc,gcd->bsgd', pooled, w_group.astype(jnp.float32)).reshape(B, S, D)
    y = y * scale.astype(jnp.float32)
    return y.astype(h.dtype), hp[:, -P:]


def short_conv(u, past, w):
    S = u.shape[1]
    up = jnp.concatenate([past.astype(u.dtype), u], axis=1)
    out = up[:, 0:S] * w[0]
    for j in range(1, CONV_W):
        out = out + up[:, j:j + S] * w[j]
    return jax.nn.silu(out), up[:, -(CONV_W - 1):]


def chunk_gated_delta(q, k, v, beta, g, s0):
    B, S, H, _ = q.shape
    C = CHUNK if S >= CHUNK else S
    pad = (-S) % C
    if pad:
        q, k, v = [jnp.pad(t, ((0, 0), (0, pad), (0, 0), (0, 0))) for t in (q, k, v)]
        beta, g = [jnp.pad(t, ((0, 0), (0, pad), (0, 0))) for t in (beta, g)]
    N = (S + pad) // C

    def chunks(t):
        t = jnp.moveaxis(t, 2, 1)
        return t.reshape((B, H, N, C) + t.shape[3:])

    q, k, v, beta, g = [chunks(t) for t in (q, k, v, beta, g)]
    gc = jnp.cumsum(g, axis=-1)
    causal = jnp.tril(jnp.ones((C, C), dtype=bool))
    strict = jnp.tril(jnp.ones((C, C), dtype=bool), -1)
    decay = jnp.exp(jnp.where(causal, gc[..., :, None] - gc[..., None, :], -jnp.inf))
    kb = k * beta[..., None]
    vb = v * beta[..., None]
    lower = jnp.where(strict, jnp.einsum('bhnid,bhnjd->bhnij', kb, k) * decay, 0.0)
    eye = jnp.eye(C, dtype=jnp.float32)
    a_mat = eye + lower
    t_mat = lax.linalg.triangular_solve(a_mat, jnp.broadcast_to(eye, a_mat.shape),
                                        left_side=True, lower=True, unit_diagonal=True)
    u = jnp.einsum('bhnij,bhnje->bhnie', t_mat, vb)
    w = jnp.einsum('bhnij,bhnjd->bhnid', t_mat, kb * jnp.exp(gc)[..., None])
    attn = jnp.einsum('bhnid,bhnjd->bhnij', q, k) * decay
    xs = [jnp.moveaxis(t, 2, 0) for t in (q, k, u, w, gc, attn)]

    def step(state, inp):
        qi, ki, ui, wi, gi, ai = inp
        v_new = ui - jnp.einsum('bhcd,bhde->bhce', wi, state)
        o = (jnp.einsum('bhcd,bhde->bhce', qi * jnp.exp(gi)[..., None], state)
             + jnp.einsum('bhcj,bhje->bhce', ai, v_new))
        g_last = gi[..., -1]
        k_dec = ki * jnp.exp(g_last[..., None] - gi)[..., None]
        state = state * jnp.exp(g_last)[..., None, None] + jnp.einsum('bhcd,bhce->bhde', k_dec, v_new)
        return state, o

    s_final, o = lax.scan(step, s0, xs)
    o = jnp.moveaxis(o, 0, 2).reshape(B, H, N * C, -1)
    o = jnp.moveaxis(o, 1, 2)[:, :S]
    return o, s_final


def gated_deltanet(h, conv_past, s0, w_in, conv_w, a_log, dt_bias, norm_w, w_out):
    B, S, _ = h.shape
    proj = h @ w_in
    qkv_raw = proj[..., :CONV_DIM]
    z = proj[..., CONV_DIM:CONV_DIM + VAL_DIM]
    b = proj[..., CONV_DIM + VAL_DIM:CONV_DIM + VAL_DIM + HV]
    a = proj[..., CONV_DIM + VAL_DIM + HV:]
    qkv, new_conv = short_conv(qkv_raw, conv_past, conv_w)
    qkv = qkv.astype(jnp.float32)
    q = l2norm(qkv[..., :KEY_DIM].reshape(B, S, HK, DK))
    k = l2norm(qkv[..., KEY_DIM:2 * KEY_DIM].reshape(B, S, HK, DK))
    v = qkv[..., 2 * KEY_DIM:].reshape(B, S, HV, DV)
    q = jnp.repeat(q, HV // HK, axis=2) * (DK ** -0.5)
    k = jnp.repeat(k, HV // HK, axis=2)
    beta = jax.nn.sigmoid(b.astype(jnp.float32))
    g = -jnp.exp(a_log.astype(jnp.float32)) * jax.nn.softplus(a.astype(jnp.float32) + dt_bias.astype(jnp.float32))
    o, s_new = chunk_gated_delta(q, k, v, beta, g, s0.astype(jnp.float32))
    o = rmsnorm(o, norm_w) * jax.nn.silu(z.astype(jnp.float32).reshape(B, S, HV, DV))
    y = o.reshape(B, S, VAL_DIM).astype(h.dtype) @ w_out
    return y, new_conv, s_new.astype(s0.dtype)


def trunk(x, st_pool, st_conv, st_delta, pos0, p):
    new_pool, new_conv, new_delta = [], [], []
    for i in range(DEPTH):
        ng = p['norm_gains'][i]
        x = x + 0.5 * rmsnorm(swiglu(rmsnorm(x, ng[0]), p['w_ffn_gate'][i, 0],
                                     p['w_ffn_up'][i, 0], p['w_ffn_down'][i, 0]), ng[1])
        h = rmsnorm(x, ng[2])
        j = i // N_MIXERS
        if i % N_MIXERS == 0:
            y, ps = pool_mixer(h, st_pool[j], pos0, p['pool_w'][j], p['pool_scale'][j])
            new_pool.append(ps)
        else:
            y, cs, ds = gated_deltanet(h, st_conv[j], st_delta[j], p['dn_w_in'][j], p['dn_conv_w'][j],
                                       p['dn_a_log'][j], p['dn_dt_bias'][j], p['dn_norm_w'][j],
                                       p['dn_w_out'][j])
            new_conv.append(cs)
            new_delta.append(ds)
        x = x + rmsnorm(y, ng[3])
        x = x + 0.5 * rmsnorm(swiglu(rmsnorm(x, ng[4]), p['w_ffn_gate'][i, 1],
                                     p['w_ffn_up'][i, 1], p['w_ffn_down'][i, 1]), ng[5])
    return x, jnp.stack(new_pool), jnp.stack(new_conv), jnp.stack(new_delta)


def setup_inputs(seed: int = 0) -> dict:
    key = jax.random.key(seed)
    ks = jax.random.split(key, 20)
    f32 = jnp.float32
    nrm = lambda k, shape, s: jax.random.normal(k, shape, f32) * s
    x_prompt = nrm(ks[0], (BATCH, SEQ, D_MODEL), 1.0)
    x_sample = nrm(ks[1], (DEC_BATCH, DEC_SEQ, D_MODEL), 1.0)
    state_pool = nrm(ks[2], (N_POOL, DEC_BATCH, POOL_MAX - 1, D_MODEL), 1.0)
    state_conv = nrm(ks[3], (N_DN, DEC_BATCH, CONV_W - 1, CONV_DIM), 1.0)
    state_delta = nrm(ks[4], (N_DN, DEC_BATCH, HV, DK, DV), 0.05)
    norm_gains = 1.0 + nrm(ks[5], (DEPTH, 6, D_MODEL), 0.02)
    w_ffn_gate = nrm(ks[6], (DEPTH, 2, D_MODEL, D_FF), D_MODEL ** -0.5)
    w_ffn_up = nrm(ks[7], (DEPTH, 2, D_MODEL, D_FF), D_MODEL ** -0.5)
    w_ffn_down = nrm(ks[8], (DEPTH, 2, D_FF, D_MODEL), D_FF ** -0.5)
    pool_w = nrm(ks[9], (N_POOL, N_POOL_GROUPS, POOL_GROUP, POOL_GROUP), POOL_GROUP ** -0.5)
    pool_scale = 1.0 + nrm(ks[10], (N_POOL, D_MODEL), 0.1)
    dn_w_in = nrm(ks[11], (N_DN, D_MODEL, IN_DIM), D_MODEL ** -0.5)
    dn_conv_w = nrm(ks[12], (N_DN, CONV_W, CONV_DIM), CONV_W ** -0.5)
    dn_a_log = jnp.log(jax.random.uniform(ks[13], (N_DN, HV), f32, 1.0, 16.0))
    dt = jnp.exp(jax.random.uniform(ks[14], (N_DN, HV), f32, np.log(1e-3), np.log(1e-1)))
    dn_dt_bias = dt + jnp.log(-jnp.expm1(-dt))
    dn_norm_w = 1.0 + nrm(ks[15], (N_DN, DV), 0.02)
    dn_w_out = nrm(ks[16], (N_DN, VAL_DIM, D_MODEL), VAL_DIM ** -0.5)
    return {'x_prompt': x_prompt, 'x_sample': x_sample, 'state_pool': state_pool,
            'state_conv': state_conv, 'state_delta': state_delta, 'norm_gains': norm_gains,
            'w_ffn_gate': w_ffn_gate, 'w_ffn_up': w_ffn_up, 'w_ffn_down': w_ffn_down,
            'pool_w': pool_w, 'pool_scale': pool_scale, 'dn_w_in': dn_w_in, 'dn_conv_w': dn_conv_w,
            'dn_a_log': dn_a_log, 'dn_dt_bias': dn_dt_bias, 'dn_norm_w': dn_norm_w, 'dn_w_out': dn_w_out}


def reference(x_prompt, x_sample, state_pool, state_conv, state_delta, norm_gains, w_ffn_gate,
              w_ffn_up, w_ffn_down, pool_w, pool_scale, dn_w_in, dn_conv_w, dn_a_log, dn_dt_bias,
              dn_norm_w, dn_w_out):
    p = {'norm_gains': norm_gains, 'w_ffn_gate': w_ffn_gate, 'w_ffn_up': w_ffn_up,
         'w_ffn_down': w_ffn_down, 'pool_w': pool_w, 'pool_scale': pool_scale, 'dn_w_in': dn_w_in,
         'dn_conv_w': dn_conv_w, 'dn_a_log': dn_a_log, 'dn_dt_bias': dn_dt_bias,
         'dn_norm_w': dn_norm_w, 'dn_w_out': dn_w_out}
    zp = jnp.zeros((N_POOL, BATCH, POOL_MAX - 1, D_MODEL), x_prompt.dtype)
    zc = jnp.zeros((N_DN, BATCH, CONV_W - 1, CONV_DIM), x_prompt.dtype)
    zd = jnp.zeros((N_DN, BATCH, HV, DK, DV), state_delta.dtype)
    y_prompt, pool_p, conv_p, delta_p = trunk(x_prompt, zp, zc, zd, 0, p)
    y_sample, pool_s, conv_s, delta_s = trunk(x_sample, state_pool, state_conv, state_delta, PAST_LEN, p)
    return (y_prompt, y_sample, pool_p, conv_p, delta_p, pool_s, conv_s, delta_s)
```

```cpp
#include <hip/hip_runtime.h>
#include <hip/hip_cooperative_groups.h>
#include <cstdio>
namespace cg = cooperative_groups;

#define LAS __attribute__((address_space(3)))
typedef unsigned short bf16_t;
typedef short bf16x8 __attribute__((ext_vector_type(8)));
typedef float f32x4 __attribute__((ext_vector_type(4)));
typedef float f32x2 __attribute__((ext_vector_type(2)));
typedef unsigned u32x4 __attribute__((ext_vector_type(4)));
typedef unsigned u32x2 __attribute__((ext_vector_type(2)));

constexpr int D = 1024, FF = 2816, SEQ = 2048, NB = 8, DB = 128, DS = 4;
constexpr int TP = NB * SEQ, TS = DB * DS, T = TP + TS;
constexpr int CONV_DIM = 4096, IN_DIM = 6176, IN_PAD = 6400, VAL_DIM = 2048, HV = 16;
constexpr float EPS = 1e-6f;
constexpr int NTHREADS = 512;
constexpr int LDS_BYTES = 132 * 1024;

constexpr size_t SZ_WGU = (size_t)2 * FF * D * 2, SZ_WDN = (size_t)D * FF * 2, SZ_WIN = (size_t)IN_PAD * D * 2, SZ_WOUT = (size_t)D * VAL_DIM * 2, SZ_WPOOL = (size_t)D * 256 * 2;
constexpr size_t WS_WGU = 0;
constexpr size_t WS_WDN = WS_WGU + 8 * SZ_WGU;
constexpr size_t WS_WIN = WS_WDN + 8 * SZ_WDN;
constexpr size_t WS_WOUT = WS_WIN + 2 * SZ_WIN;
constexpr size_t WS_WPOOL = WS_WOUT + 2 * SZ_WOUT;
constexpr size_t WS_HN = WS_WPOOL + 2 * SZ_WPOOL;
constexpr size_t WS_H = WS_HN + (size_t)T * D * 2;
constexpr size_t WS_Y = WS_H + (size_t)T * FF * 2;
constexpr size_t WS_PROJ = WS_Y + (size_t)T * D * 4;
constexpr size_t WS_END = WS_PROJ + (size_t)T * IN_PAD * 2;

constexpr size_t O_Y = 0;
constexpr size_t O_POOLP = (size_t)T * D;
constexpr size_t O_CONVP = O_POOLP + (size_t)2 * NB * 15 * D;
constexpr size_t O_DELTAP = O_CONVP + (size_t)2 * NB * 3 * CONV_DIM;
constexpr size_t O_POOLS = O_DELTAP + (size_t)2 * NB * HV * 16384;
constexpr size_t O_CONVS = O_POOLS + (size_t)2 * DB * 15 * D;
constexpr size_t O_DELTAS = O_CONVS + (size_t)2 * DB * 3 * CONV_DIM;

struct Params {
    const float* x_prompt; const float* x_sample; const float* state_pool; const float* state_conv; const float* state_delta; const float* norm_gains;
    const float* w_gate; const float* w_up; const float* w_down; const float* pool_w; const float* pool_scale; const float* dn_w_in; const float* dn_conv_w;
    const float* dn_a_log; const float* dn_dt_bias; const float* dn_norm_w; const float* dn_w_out;
    float* out; unsigned char* ws;
};

__device__ __forceinline__ unsigned cvt_pk_bf16(float lo, float hi) { unsigned r; asm volatile("v_cvt_pk_bf16_f32 %0, %1, %2" : "=v"(r) : "v"(lo), "v"(hi)); return r; }
__device__ __forceinline__ float bf2f(bf16_t b) { return __uint_as_float(((unsigned)b) << 16); }
__device__ __forceinline__ float bflo(unsigned w) { return __uint_as_float(w << 16); }
__device__ __forceinline__ float bfhi(unsigned w) { return __uint_as_float(w & 0xffff0000u); }
__device__ __forceinline__ float silu_f(float x) { return x * __builtin_amdgcn_rcpf(1.0f + __builtin_amdgcn_exp2f(-1.44269504089f * x)); }
__device__ __forceinline__ float wave_sum(float v) {
#pragma unroll
    for (int o = 32; o >= 1; o >>= 1) v += __shfl_xor(v, o);
    return v;
}
__device__ __forceinline__ int opaque_tid() { int t = threadIdx.x; asm volatile("" : "+v"(t)); return t; }
template <int CTRL> __device__ __forceinline__ float dppf(float x) { return __builtin_bit_cast(float, __builtin_amdgcn_mov_dpp(__builtin_bit_cast(int, x), CTRL, 0xf, 0xf, true)); }
__device__ __forceinline__ float red8(float x) { x += dppf<0xB1>(x); x += dppf<0x4E>(x); x += dppf<0x141>(x); return x; }

namespace pg8 {
constexpr int BM = 256, BK = 64, HALF = 128, HTB = HALF * BK * 2, STAGE_BYTES = 8 * HTB, NXCD = 8, WGM = 8;
__device__ __forceinline__ int lds_byte(int r, int c) { const int st = (r >> 4) * 2 + (c >> 5), rr = r & 15, cc = c & 31, ob = rr * 64 + cc * 2; return st * 1024 + (ob ^ (((ob >> 9) & 1) << 5)); }
__device__ __forceinline__ void stage_rc(int b, int& R, int& C) { const int st = b / 1024, sb = b % 1024, swz = sb ^ (((sb >> 9) & 1) << 5); R = (st >> 1) * 16 + swz / 64; C = (st & 1) * 32 + (swz % 64) / 2; }
__device__ __forceinline__ int perm32(int rho) { const int n = rho >> 4, i = rho & 15; return 8 * (i >> 2) + 4 * n + (i & 3); }

struct Unit { int pm, pn; };
struct Gemm { const bf16_t* A; const bf16_t* Bt; int K, lda, ldb, acol; };

struct StaticOrder {
    int nM, nN, nwg, G, c;
    __device__ void init(int M, int N, int G_, int c_) { nM = M / BM; nN = N / BM; nwg = nM * nN; G = G_; c = c_; }
    __device__ bool next(int i, Unit& u) const {
        const long L = (long)i * G + c; if (L >= nwg) return false;
        int wgid = (int)L; { const int q = nwg / NXCD, r = nwg % NXCD, xcd = wgid % NXCD, off = wgid / NXCD; wgid = (xcd < r ? xcd * (q + 1) : r * (q + 1) + (xcd - r) * q) + off; }
        const int nig = WGM * nN, gid = wgid / nig, fm = gid * WGM, gsz = (nM - fm) < WGM ? (nM - fm) : WGM;
        u.pm = fm + ((wgid % nig) % gsz); u.pn = (wgid % nig) / gsz; return true;
    }
};

struct EpiF32 {
    static constexpr bool PERM = false;
    float* C; int ldc; const float* scale;
    __device__ __forceinline__ void operator()(const f32x4 (&acc)[2][2][4][2], const Unit& u, int wr, int wc, int fr, int fq) const {
        const int row0 = u.pm * BM + wr * 64 + fr, col0 = u.pn * BM + wc * 32 + 4 * fq;
        f32x4 sv[2][2];
#pragma unroll
        for (int bj = 0; bj < 2; ++bj)
#pragma unroll
            for (int n = 0; n < 2; ++n) sv[bj][n] = scale ? *(const f32x4*)(scale + col0 + bj * HALF + n * 16) : (f32x4){1.f, 1.f, 1.f, 1.f};
#pragma unroll
        for (int ai = 0; ai < 2; ++ai)
#pragma unroll
            for (int m = 0; m < 4; ++m) { float* rowp = C + (size_t)(row0 + ai * HALF + m * 16) * ldc + col0;
#pragma unroll
                for (int bj = 0; bj < 2; ++bj)
#pragma unroll
                    for (int n = 0; n < 2; ++n) *(f32x4*)(rowp + bj * HALF + n * 16) = acc[ai][bj][m][n] * sv[bj][n]; }
    }
};
struct EpiBf16 {
    static constexpr bool PERM = true;
    bf16_t* O; int ldc;
    __device__ __forceinline__ void operator()(const f32x4 (&acc)[2][2][4][2], const Unit& u, int wr, int wc, int fr, int fq) const {
        const int row0 = u.pm * BM + wr * 64 + fr, col0 = u.pn * BM + wc * 32 + 8 * fq;
#pragma unroll
        for (int ai = 0; ai < 2; ++ai)
#pragma unroll
            for (int m = 0; m < 4; ++m) { bf16_t* rowp = O + (size_t)(row0 + ai * HALF + m * 16) * ldc + col0;
#pragma unroll
                for (int bj = 0; bj < 2; ++bj) { const f32x4 v0 = acc[ai][bj][m][0], v1 = acc[ai][bj][m][1];
                    u32x4 w; w.x = cvt_pk_bf16(v0[0], v0[1]); w.y = cvt_pk_bf16(v0[2], v0[3]); w.z = cvt_pk_bf16(v1[0], v1[1]); w.w = cvt_pk_bf16(v1[2], v1[3]);
                    *(u32x4*)(rowp + bj * HALF) = w; } }
    }
};
struct EpiSwiGLU {
    static constexpr bool PERM = true;
    bf16_t* O; int ldc;
    __device__ __forceinline__ void operator()(const f32x4 (&acc)[2][2][4][2], const Unit& u, int wr, int wc, int fr, int fq) const {
        const int row0 = u.pm * BM + wr * 64 + fr, col0 = u.pn * HALF + wc * 32 + 8 * fq;
#pragma unroll
        for (int ai = 0; ai < 2; ++ai)
#pragma unroll
            for (int m = 0; m < 4; ++m) { bf16_t* rowp = O + (size_t)(row0 + ai * HALF + m * 16) * ldc + col0;
                const f32x4 g0 = acc[ai][0][m][0], g1 = acc[ai][0][m][1], u0 = acc[ai][1][m][0], u1 = acc[ai][1][m][1];
                u32x4 w; w.x = cvt_pk_bf16(silu_f(g0[0]) * u0[0], silu_f(g0[1]) * u0[1]); w.y = cvt_pk_bf16(silu_f(g0[2]) * u0[2], silu_f(g0[3]) * u0[3]);
                w.z = cvt_pk_bf16(silu_f(g1[0]) * u1[0], silu_f(g1[1]) * u1[1]); w.w = cvt_pk_bf16(silu_f(g1[2]) * u1[2], silu_f(g1[3]) * u1[3]);
                *(u32x4*)rowp = w; }
    }
};

template <class Epi, class Sched>
__device__ __forceinline__ void gemm_phase(LAS unsigned char* lds, const Gemm g, const Sched& S, const Epi& E) {
    const int tid = opaque_tid(), wid = __builtin_amdgcn_readfirstlane(tid >> 6), lane = tid & 63, wr = wid >> 2, wc = wid & 3, fr = lane & 15, fq = lane >> 4;
    const int K = g.K, nt = K / BK;
    unsigned voffA[2], voffB[2];
#pragma unroll
    for (int i = 0; i < 2; ++i) { int R, C; stage_rc(tid * 16 + i * 8192, R, C); const int Rb = Epi::PERM ? ((R & ~31) + perm32(R & 31)) : R;
        voffA[i] = (unsigned)(R * g.lda + C) * 2u; voffB[i] = (unsigned)(Rb * g.ldb + C) * 2u; }
    const size_t kstep = (size_t)(BK * 2);
    const size_t hstepA = (size_t)HALF * g.lda * 2, hstepB = (size_t)HALF * g.ldb * 2;
    const size_t tstepA = 2 * hstepA, tstepB = 2 * hstepB;
    const unsigned ldsw = (unsigned)wid * 1024u;
    const int aoff = lds_byte(wr * 64 + fr, fq * 8), boff = lds_byte(wc * 32 + fr, fq * 8);
#define PG8_SA(b, h) (((b) * 2 + (h)) * HTB)
#define PG8_SB(b, h) ((4 + (b) * 2 + (h)) * HTB)
#define PG8_STAGE(bufoff, gbase, voff) do { _Pragma("unroll") for (int _i = 0; _i < 2; ++_i) \
        __builtin_amdgcn_global_load_lds((const unsigned*)((const char*)(gbase) + (voff)[_i]), (LAS unsigned*)(lds + (bufoff) + ldsw + _i * 8192), 16, 0, 0); } while (0)
#define PG8_LDA(dst, b, h) do { _Pragma("unroll") for (int m = 0; m < 4; ++m) _Pragma("unroll") for (int k = 0; k < 2; ++k) dst[m][k] = *(const LAS bf16x8*)(lds + PG8_SA(b, h) + aoff + m * 2048 + k * 1024); } while (0)
#define PG8_LDB(dst, b, h) do { _Pragma("unroll") for (int n = 0; n < 2; ++n) _Pragma("unroll") for (int k = 0; k < 2; ++k) dst[n][k] = *(const LAS bf16x8*)(lds + PG8_SB(b, h) + boff + n * 2048 + k * 1024); } while (0)
#define PG8_MMA(ai, bj, At, Bt) do { __builtin_amdgcn_s_setprio(1); _Pragma("unroll") for (int m = 0; m < 4; ++m) _Pragma("unroll") for (int n = 0; n < 2; ++n) _Pragma("unroll") for (int k = 0; k < 2; ++k) \
        acc[ai][bj][m][n] = __builtin_amdgcn_mfma_f32_16x16x32_bf16(Bt[n][k], At[m][k], acc[ai][bj][m][n], 0, 0, 0); __builtin_amdgcn_s_setprio(0); } while (0)
#define PG8_WAIT_V(n) asm volatile("s_waitcnt vmcnt(" #n ")" ::: "memory")
#define PG8_WAIT_L(n) asm volatile("s_waitcnt lgkmcnt(" #n ")" ::: "memory")
#define PG8_BAR __builtin_amdgcn_s_barrier()
#define PG8_SCHED __builtin_amdgcn_sched_barrier(0)
    Unit cur, nxt; int ui = 0;
    if (!S.next(0, cur)) return;
    f32x4 acc[2][2][4][2];
#pragma unroll
    for (int a = 0; a < 2; ++a)
#pragma unroll
        for (int b = 0; b < 2; ++b)
#pragma unroll
            for (int m = 0; m < 4; ++m)
#pragma unroll
                for (int n = 0; n < 2; ++n) acc[a][b][m][n] = (f32x4){0.f, 0.f, 0.f, 0.f};
    bf16x8 At[4][2], B0[2][2], B1[2][2];
    const char* cA = (const char*)g.A + (size_t)cur.pm * tstepA + (size_t)cur.pn * g.acol * 2; const char* cB = (const char*)g.Bt + (size_t)cur.pn * tstepB;
    PG8_STAGE(PG8_SB(0, 0), cB, voffB); PG8_STAGE(PG8_SA(0, 0), cA, voffA); PG8_STAGE(PG8_SB(0, 1), cB + hstepB, voffB); PG8_STAGE(PG8_SA(0, 1), cA + hstepA, voffA);
    if (wr == 1) PG8_BAR;
    PG8_WAIT_V(4); PG8_BAR;
    PG8_STAGE(PG8_SB(1, 0), cB + kstep, voffB); PG8_STAGE(PG8_SA(1, 0), cA + kstep, voffA); PG8_STAGE(PG8_SB(1, 1), cB + hstepB + kstep, voffB);
    PG8_WAIT_V(6); PG8_BAR;
    for (;;) {
        const bool has_next = S.next(ui + 1, nxt);
        const char* nA = has_next ? (const char*)g.A + (size_t)nxt.pm * tstepA + (size_t)nxt.pn * g.acol * 2 : cA; const char* nB = has_next ? (const char*)g.Bt + (size_t)nxt.pn * tstepB : cB;
        for (int t = 0; t < nt; t += 2) {
            const bool last = (t == nt - 2);
            const char* a1 = cA + (size_t)(t + 1) * kstep;
            const char* a2 = last ? nA : cA + (size_t)(t + 2) * kstep; const char* b2 = last ? nB : cB + (size_t)(t + 2) * kstep;
            const char* a3 = a2 + kstep; const char* b3 = b2 + kstep;
            PG8_LDB(B0, 0, 0); PG8_SCHED; PG8_LDA(At, 0, 0); PG8_STAGE(PG8_SA(1, 1), a1 + hstepA, voffA);
            PG8_WAIT_L(8); PG8_BAR; PG8_WAIT_L(0); PG8_MMA(0, 0, At, B0); PG8_BAR; PG8_SCHED;
            PG8_LDB(B1, 0, 1); PG8_STAGE(PG8_SB(0, 0), b2, voffB);
            PG8_BAR; PG8_WAIT_L(0); PG8_MMA(0, 1, At, B1); PG8_BAR;
            PG8_LDA(At, 0, 1); PG8_STAGE(PG8_SA(0, 0), a2, voffA);
            PG8_BAR; PG8_WAIT_L(0); PG8_MMA(1, 0, At, B0); PG8_BAR; PG8_SCHED;
            PG8_STAGE(PG8_SB(0, 1), b2 + hstepB, voffB);
            PG8_WAIT_V(6); PG8_BAR; PG8_MMA(1, 1, At, B1); PG8_BAR;
            PG8_LDB(B0, 1, 0); PG8_SCHED; PG8_LDA(At, 1, 0); PG8_STAGE(PG8_SA(0, 1), a2 + hstepA, voffA);
            PG8_WAIT_L(8); PG8_BAR; PG8_WAIT_L(0); PG8_MMA(0, 0, At, B0); PG8_BAR; PG8_SCHED;
            PG8_LDB(B1, 1, 1); PG8_STAGE(PG8_SB(1, 0), b3, voffB);
            PG8_BAR; PG8_WAIT_L(0); PG8_MMA(0, 1, At, B1); PG8_BAR;
            PG8_LDA(At, 1, 1); PG8_STAGE(PG8_SA(1, 0), a3, voffA);
            PG8_BAR; PG8_WAIT_L(0); PG8_MMA(1, 0, At, B0); PG8_BAR; PG8_SCHED;
            PG8_STAGE(PG8_SB(1, 1), b3 + hstepB, voffB);
            PG8_WAIT_V(6); PG8_BAR; PG8_MMA(1, 1, At, B1); PG8_BAR;
        }
        E(acc, cur, wr, wc, fr, fq);
        if (!has_next) break;
#pragma unroll
        for (int a = 0; a < 2; ++a)
#pragma unroll
            for (int b = 0; b < 2; ++b)
#pragma unroll
                for (int m = 0; m < 4; ++m)
#pragma unroll
                    for (int n = 0; n < 2; ++n) acc[a][b][m][n] = (f32x4){0.f, 0.f, 0.f, 0.f};
        cur = nxt; cA = nA; cB = nB; ++ui;
    }
    PG8_WAIT_V(0);
    if (wr == 0) PG8_BAR;
    PG8_BAR;
#undef PG8_SA
#undef PG8_SB
#undef PG8_STAGE
#undef PG8_LDA
#undef PG8_LDB
#undef PG8_MMA
#undef PG8_WAIT_V
#undef PG8_WAIT_L
#undef PG8_BAR
#undef PG8_SCHED
}
}

constexpr int CT_GU = 8 * 16 * 88, CT_DN = 8 * 44 * 16, CT_IN = 2 * 16 * 100, CT_OUT = 2 * 32 * 16, CT_POOL = 8 * 4 * 4;
constexpr int CT_TOTAL = CT_GU + CT_DN + CT_IN + CT_OUT + CT_POOL;

__device__ __forceinline__ void convert_weights(LAS float* tile, const Params& P) {
    const int tid = opaque_tid();
    for (int t = blockIdx.x; t < CT_TOTAL; t += gridDim.x) {
        const float* src; int ldsrc, k0, n0, nvalid, lddst, dstrow0; bf16_t* dst;
        if (t < CT_GU) { const int l = t / 1408, rem = t % 1408, kt = rem % 16, rt = rem / 16, r0 = rt * 64, pn = r0 >> 8, bj = (r0 >> 7) & 1, j0 = r0 & 127;
            src = (bj ? P.w_up : P.w_gate) + (size_t)l * D * FF; ldsrc = FF; k0 = kt * 64; n0 = 128 * pn + j0; nvalid = FF; dst = (bf16_t*)(P.ws + WS_WGU + l * SZ_WGU); lddst = D; dstrow0 = r0; }
        else if (t < CT_GU + CT_DN) { const int tt = t - CT_GU, l = tt / 704, rem = tt % 704, kt = rem % 44, nt_ = rem / 44;
            src = P.w_down + (size_t)l * FF * D; ldsrc = D; k0 = kt * 64; n0 = nt_ * 64; nvalid = D; dst = (bf16_t*)(P.ws + WS_WDN + l * SZ_WDN); lddst = FF; dstrow0 = n0; }
        else if (t < CT_GU + CT_DN + CT_IN) { const int tt = t - CT_GU - CT_DN, l = tt / 1600, rem = tt % 1600, kt = rem % 16, nt_ = rem / 16;
            src = P.dn_w_in + (size_t)l * D * IN_DIM; ldsrc = IN_DIM; k0 = kt * 64; n0 = nt_ * 64; nvalid = IN_DIM; dst = (bf16_t*)(P.ws + WS_WIN + l * SZ_WIN); lddst = D; dstrow0 = n0; }
        else if (t < CT_GU + CT_DN + CT_IN + CT_OUT) { const int tt = t - CT_GU - CT_DN - CT_IN, l = tt / 512, rem = tt % 512, kt = rem % 32, nt_ = rem / 32;
            src = P.dn_w_out + (size_t)l * VAL_DIM * D; ldsrc = D; k0 = kt * 64; n0 = nt_ * 64; nvalid = D; dst = (bf16_t*)(P.ws + WS_WOUT + l * SZ_WOUT); lddst = VAL_DIM; dstrow0 = n0; }
        else { const int tt = t - CT_GU - CT_DN - CT_IN - CT_OUT, mtx = tt / 16, rem = tt % 16, kt = rem % 4, nt_ = rem / 4;
            src = P.pool_w + (size_t)mtx * 65536; ldsrc = 256; k0 = kt * 64; n0 = nt_ * 64; nvalid = 256; dst = (bf16_t*)(P.ws + WS_WPOOL) + (size_t)mtx * 65536; lddst = 256; dstrow0 = n0; }
        {   const int rr = tid >> 4, c4 = tid & 15, n = n0 + c4 * 4;
#pragma unroll
            for (int h = 0; h < 2; ++h) { const int k = rr + h * 32;
                f32x4 v = (f32x4){0.f, 0.f, 0.f, 0.f};
                if (n < nvalid) v = *(const f32x4*)(src + (size_t)(k0 + k) * ldsrc + n);
                LAS float* tp = tile + k * 65 + c4 * 4; tp[0] = v[0]; tp[1] = v[1]; tp[2] = v[2]; tp[3] = v[3]; }
        }
        __syncthreads();
        {   const int n = tid >> 3, kg = tid & 7; const LAS float* tp = tile + (kg * 8) * 65 + n;
            u32x4 w; w.x = cvt_pk_bf16(tp[0], tp[65]); w.y = cvt_pk_bf16(tp[130], tp[195]); w.z = cvt_pk_bf16(tp[260], tp[325]); w.w = cvt_pk_bf16(tp[390], tp[455]);
            *(u32x4*)(dst + (size_t)(dstrow0 + n) * lddst + k0 + kg * 8) = w;
        }
        __syncthreads();
    }
}

__device__ __forceinline__ void row_pass(const Params& P, int mode, float coef, const float* gpost, const float* gnext, int pool_j) {
    const int tid = opaque_tid(), lane = tid & 63, wv = tid >> 6;
    float* X = P.out + O_Y; const float* Y = (const float*)(P.ws + WS_Y); bf16_t* HN = (bf16_t*)(P.ws + WS_HN);
    for (int row = blockIdx.x * 8 + wv; row < T; row += gridDim.x * 8) {
        f32x4 x[4];
        if (mode == 0) { const float* src = row < TP ? P.x_prompt + (size_t)row * D : P.x_sample + (size_t)(row - TP) * D;
#pragma unroll
            for (int i = 0; i < 4; ++i) x[i] = *(const f32x4*)(src + i * 256 + lane * 4); }
        else { f32x4 y[4]; float ss = 0.f;
#pragma unroll
            for (int i = 0; i < 4; ++i) { y[i] = *(const f32x4*)(Y + (size_t)row * D + i * 256 + lane * 4); x[i] = *(const f32x4*)(X + (size_t)row * D + i * 256 + lane * 4);
                ss += y[i][0] * y[i][0] + y[i][1] * y[i][1] + y[i][2] * y[i][2] + y[i][3] * y[i][3]; }
            ss = wave_sum(ss); const float r = coef * __builtin_amdgcn_rsqf(ss * (1.0f / D) + EPS);
#pragma unroll
            for (int i = 0; i < 4; ++i) { const f32x4 gp = *(const f32x4*)(gpost + i * 256 + lane * 4); x[i] += y[i] * gp * r; } }
#pragma unroll
        for (int i = 0; i < 4; ++i) *(f32x4*)(X + (size_t)row * D + i * 256 + lane * 4) = x[i];
        if (gnext) { float ss = 0.f;
#pragma unroll
            for (int i = 0; i < 4; ++i) ss += x[i][0] * x[i][0] + x[i][1] * x[i][1] + x[i][2] * x[i][2] + x[i][3] * x[i][3];
            ss = wave_sum(ss); const float r = __builtin_amdgcn_rsqf(ss * (1.0f / D) + EPS);
            float* pdst = nullptr;
            if (pool_j >= 0) { if (row < TP) { const int b = row / SEQ, s = row % SEQ; if (s >= SEQ - 15) pdst = P.out + O_POOLP + ((size_t)(pool_j * NB + b) * 15 + (s - (SEQ - 15))) * D; }
                               else { const int b = (row - TP) / DS, s = (row - TP) % DS; pdst = P.out + O_POOLS + ((size_t)(pool_j * DB + b) * 15 + 11 + s) * D; } }
#pragma unroll
            for (int i = 0; i < 4; ++i) { const f32x4 gn = *(const f32x4*)(gnext + i * 256 + lane * 4); const f32x4 h = x[i] * gn * r;
                u32x2 w; w.x = cvt_pk_bf16(h[0], h[1]); w.y = cvt_pk_bf16(h[2], h[3]); *(u32x2*)(HN + (size_t)row * D + i * 256 + lane * 4) = w;
                if (pdst) *(f32x4*)(pdst + i * 256 + lane * 4) = h; } }
    }
}

__device__ __forceinline__ void pool_pass(const Params& P, int j) {
    const bf16_t* HN = (const bf16_t*)(P.ws + WS_HN); bf16_t* PO = (bf16_t*)(P.ws + WS_H);
    const float* past = P.state_pool + (size_t)j * DB * 15 * D;
    const size_t gtid = (size_t)blockIdx.x * NTHREADS + opaque_tid(), gsz = (size_t)gridDim.x * NTHREADS;
    for (size_t it = gtid; it < (size_t)T * 128; it += gsz) {
        const int row = (int)(it >> 7), ch = (int)(it & 127), col = ch * 8, w = 2 << (ch >> 5);
        float a[8];
#pragma unroll
        for (int q = 0; q < 8; ++q) a[q] = 0.f;
        const u32x4 self = *(const u32x4*)(HN + (size_t)row * D + col);
        float cnt;
        if (row < TP) { const int s = row % SEQ; const int n = (s + 1 < w) ? s + 1 : w; cnt = (float)n;
            for (int i = 0; i < n; ++i) { const u32x4 v = *(const u32x4*)(HN + (size_t)(row - i) * D + col);
                a[0] += bflo(v.x); a[1] += bfhi(v.x); a[2] += bflo(v.y); a[3] += bfhi(v.y); a[4] += bflo(v.z); a[5] += bfhi(v.z); a[6] += bflo(v.w); a[7] += bfhi(v.w); } }
        else { const int b = (row - TP) / DS, s = (row - TP) % DS; cnt = (float)w;
            for (int i = 0; i < w; ++i) {
                if (s - i >= 0) { const u32x4 v = *(const u32x4*)(HN + (size_t)(row - i) * D + col);
                    a[0] += bflo(v.x); a[1] += bfhi(v.x); a[2] += bflo(v.y); a[3] += bfhi(v.y); a[4] += bflo(v.z); a[5] += bfhi(v.z); a[6] += bflo(v.w); a[7] += bfhi(v.w); }
                else { const float* pp = past + ((size_t)b * 15 + (15 + s - i)) * D + col; const f32x4 v0 = *(const f32x4*)pp, v1 = *(const f32x4*)(pp + 4);
                    a[0] += v0[0]; a[1] += v0[1]; a[2] += v0[2]; a[3] += v0[3]; a[4] += v1[0]; a[5] += v1[1]; a[6] += v1[2]; a[7] += v1[3]; } } }
        const float ic = 1.0f / cnt;
        u32x4 o; o.x = cvt_pk_bf16(a[0] * ic - bflo(self.x), a[1] * ic - bfhi(self.x)); o.y = cvt_pk_bf16(a[2] * ic - bflo(self.y), a[3] * ic - bfhi(self.y));
        o.z = cvt_pk_bf16(a[4] * ic - bflo(self.z), a[5] * ic - bfhi(self.z)); o.w = cvt_pk_bf16(a[6] * ic - bflo(self.w), a[7] * ic - bfhi(self.w));
        *(u32x4*)(PO + (size_t)row * D + col) = o;
    }
    float* dst = P.out + O_POOLS + (size_t)j * DB * 15 * D;
    for (size_t it = gtid; it < (size_t)DB * 11 * (D / 4); it += gsz) { const int b = (int)(it / (11 * 256)), r = (int)(it % (11 * 256)), p = r / 256, c4 = r % 256;
        *(f32x4*)(dst + ((size_t)b * 15 + p) * D + c4 * 4) = *(const f32x4*)(past + ((size_t)b * 15 + p + 4) * D + c4 * 4); }
}

constexpr int TB = 32;
__device__ __forceinline__ void delta_item(LAS float* L, const Params& P, int j, bool isPrompt, int b, int hv) {
    const int tid = opaque_tid(), lane = tid & 63, wv = tid >> 6, dg = lane & 7, ep = lane >> 3, ecol = 16 * wv + 2 * ep, hk = hv >> 1;
    LAS float* qs = L; LAS float* ks = L + TB * 128; LAS float* vs = L + 2 * TB * 128; LAS float* os = L + 3 * TB * 128;
    LAS float* gs = L + 4 * TB * 128; LAS float* bs = gs + TB; LAS float* kqs = bs + TB;
    const bf16_t* proj = (const bf16_t*)(P.ws + WS_PROJ); bf16_t* OG = (bf16_t*)(P.ws + WS_H);
    const float* conv_w = P.dn_conv_w + (size_t)j * 4 * CONV_DIM; const float* normw = P.dn_norm_w + j * 128;
    const float alog = P.dn_a_log[j * HV + hv], dtb = P.dn_dt_bias[j * HV + hv];
    const int row0 = isPrompt ? b * SEQ : TP + b * DS, ntok = isPrompt ? SEQ : DS;
    const float* cpast = P.state_conv + (size_t)(j * DB + b) * 3 * CONV_DIM;
    f32x2 s[16];
    if (isPrompt) {
#pragma unroll
        for (int i = 0; i < 16; ++i) s[i] = (f32x2){0.f, 0.f}; }
    else { const float* s0 = P.state_delta + ((size_t)(j * DB + b) * HV + hv) * 16384;
#pragma unroll
        for (int i = 0; i < 16; ++i) s[i] = *(const f32x2*)(s0 + (16 * dg + i) * 128 + ecol); }
    float Gacc = 0.f;
    for (int t0 = 0; t0 < ntok; t0 += TB) {
        const int nb = (ntok - t0) < TB ? (ntok - t0) : TB;
        for (int idx = tid; idx < nb * 384; idx += NTHREADS) {
            const int tok = idx / 384, ch = idx % 384, part = ch >> 7, cc = ch & 127;
            const int col = part == 0 ? hk * 128 + cc : (part == 1 ? 1024 + hk * 128 + cc : 2048 + hv * 128 + cc);
            float acc = 0.f;
#pragma unroll
            for (int jj = 0; jj < 4; ++jj) { const int tt = t0 + tok - 3 + jj; float u;
                if (tt >= 0) u = bf2f(proj[(size_t)(row0 + tt) * IN_PAD + col]); else u = isPrompt ? 0.f : cpast[(3 + tt) * CONV_DIM + col];
                acc += u * conv_w[jj * CONV_DIM + col]; }
            L[part * TB * 128 + tok * 128 + cc] = silu_f(acc);
        }
        if (tid < nb) { const size_t r = (size_t)(row0 + t0 + tid) * IN_PAD; const float bb = bf2f(proj[r + 6144 + hv]), aa = bf2f(proj[r + 6160 + hv]) + dtb;
            bs[tid] = 1.0f / (1.0f + __expf(-bb)); const float sp = aa > 20.f ? aa : log1pf(__expf(aa)); gs[tid] = -__expf(alog) * sp; }
        __syncthreads();
        for (int tok = wv; tok < nb; tok += 8) { f32x2 q = *(LAS f32x2*)(qs + tok * 128 + lane * 2), k = *(LAS f32x2*)(ks + tok * 128 + lane * 2);
            const float sq = wave_sum(q.x * q.x + q.y * q.y), sk = wave_sum(k.x * k.x + k.y * k.y);
            const float rq = __builtin_amdgcn_rsqf(sq + EPS) * 0.08838834764831845f, rk = __builtin_amdgcn_rsqf(sk + EPS);
            q *= rq; k *= rk; *(LAS f32x2*)(qs + tok * 128 + lane * 2) = q; *(LAS f32x2*)(ks + tok * 128 + lane * 2) = k;
            const float kq = wave_sum(q.x * k.x + q.y * k.y); if (lane == 0) kqs[tok] = kq; }
        __syncthreads();
        for (int tok = 0; tok < nb; ++tok) {
            f32x4 kv[4], qv[4];
#pragma unroll
            for (int i = 0; i < 4; ++i) { kv[i] = *(const LAS f32x4*)(ks + tok * 128 + 16 * dg + 4 * i); qv[i] = *(const LAS f32x4*)(qs + tok * 128 + 16 * dg + 4 * i); }
            const f32x2 v = *(const LAS f32x2*)(vs + tok * 128 + ecol);
            const float g = gs[tok], beta = bs[tok], kq = kqs[tok];
            float Gn = Gacc + g;
            if (Gn < -30.f) { const float f = __expf(Gn);
#pragma unroll
                for (int i = 0; i < 16; ++i) s[i] *= f;
                Gn = 0.f; }
            Gacc = Gn;
            f32x2 pp = (f32x2){0.f, 0.f}, oo = (f32x2){0.f, 0.f};
#pragma unroll
            for (int i = 0; i < 16; ++i) { pp += s[i] * kv[i >> 2][i & 3]; oo += s[i] * qv[i >> 2][i & 3]; }
            pp.x = red8(pp.x); pp.y = red8(pp.y); oo.x = red8(oo.x); oo.y = red8(oo.y);
            const float c = __expf(Gacc), ic = __expf(-Gacc);
            const f32x2 dl = (v - pp * c) * beta, dt = dl * ic;
#pragma unroll
            for (int i = 0; i < 16; ++i) s[i] += dt * kv[i >> 2][i & 3];
            const f32x2 o = oo * c + dl * kq;
            if (dg == 0) *(LAS f32x2*)(os + tok * 128 + ecol) = o;
        }
        __syncthreads();
        for (int tok = wv; tok < nb; tok += 8) { const f32x2 o = *(const LAS f32x2*)(os + tok * 128 + lane * 2);
            const float ss = wave_sum(o.x * o.x + o.y * o.y), r = __builtin_amdgcn_rsqf(ss * (1.0f / 128.f) + EPS);
            const size_t rr = (size_t)(row0 + t0 + tok);
            const unsigned zz = *(const unsigned*)(proj + rr * IN_PAD + 4096 + hv * 128 + lane * 2);
            const f32x2 nw = *(const f32x2*)(normw + lane * 2);
            *(unsigned*)(OG + rr * VAL_DIM + hv * 128 + lane * 2) = cvt_pk_bf16(o.x * r * nw.x * silu_f(bflo(zz)), o.y * r * nw.y * silu_f(bfhi(zz))); }
        __syncthreads();
    }
    {   const float c = __expf(Gacc);
        float* sd = isPrompt ? P.out + O_DELTAP + ((size_t)(j * NB + b) * HV + hv) * 16384 : P.out + O_DELTAS + ((size_t)(j * DB + b) * HV + hv) * 16384;
#pragma unroll
        for (int i = 0; i < 16; ++i) *(f32x2*)(sd + (16 * dg + i) * 128 + ecol) = s[i] * c; }
}
__device__ __forceinline__ void delta_phase(LAS float* L, const Params& P, int j) {
    const int G = gridDim.x, bid = blockIdx.x;
    const bf16_t* proj = (const bf16_t*)(P.ws + WS_PROJ);
    {
        const size_t gtid = (size_t)bid * NTHREADS + opaque_tid(), gsz = (size_t)G * NTHREADS;
        for (size_t it = gtid; it < (size_t)NB * 3 * CONV_DIM; it += gsz) { const int b = (int)(it / (3 * CONV_DIM)), r = (int)(it % (3 * CONV_DIM)), p = r / CONV_DIM, c = r % CONV_DIM;
            P.out[O_CONVP + (size_t)j * NB * 3 * CONV_DIM + it] = bf2f(proj[(size_t)(b * SEQ + SEQ - 3 + p) * IN_PAD + c]); }
        for (size_t it = gtid; it < (size_t)DB * 3 * CONV_DIM; it += gsz) { const int b = (int)(it / (3 * CONV_DIM)), r = (int)(it % (3 * CONV_DIM)), p = r / CONV_DIM, c = r % CONV_DIM;
            P.out[O_CONVS + (size_t)j * DB * 3 * CONV_DIM + it] = bf2f(proj[(size_t)(TP + b * DS + 1 + p) * IN_PAD + c]); }
    }
    const int nP = NB * HV, nS = DB * HV;
    if (G >= 2 * nP) {
        if (bid < nP) delta_item(L, P, j, true, bid / HV, bid % HV);
        else for (int it = bid - nP; it < nS; it += G - nP) delta_item(L, P, j, false, it / HV, it % HV);
    } else {
        for (int it = bid; it < nP + nS; it += G) { if (it < nP) delta_item(L, P, j, true, it / HV, it % HV); else delta_item(L, P, j, false, (it - nP) / HV, (it - nP) % HV); }
    }
}

typedef const __attribute__((address_space(4))) Params* KP;
__device__ __forceinline__ Params ldp(KP kp) {
    asm volatile("" : "+s"(kp));
    Params P;
    P.x_prompt = kp->x_prompt; P.x_sample = kp->x_sample; P.state_pool = kp->state_pool; P.state_conv = kp->state_conv; P.state_delta = kp->state_delta; P.norm_gains = kp->norm_gains;
    P.w_gate = kp->w_gate; P.w_up = kp->w_up; P.w_down = kp->w_down; P.pool_w = kp->pool_w; P.pool_scale = kp->pool_scale; P.dn_w_in = kp->dn_w_in; P.dn_conv_w = kp->dn_conv_w;
    P.dn_a_log = kp->dn_a_log; P.dn_dt_bias = kp->dn_dt_bias; P.dn_norm_w = kp->dn_norm_w; P.dn_w_out = kp->dn_w_out; P.out = kp->out; P.ws = kp->ws;
    return P;
}
__global__ void __launch_bounds__(NTHREADS, 2) mk_fwd(Params Punused) {
    extern __shared__ __attribute__((aligned(16))) unsigned char lds_raw[];
    LAS unsigned char* lds = (LAS unsigned char*)lds_raw;
    cg::grid_group grid = cg::this_grid();
    KP kp = (KP)__builtin_amdgcn_kernarg_segment_ptr();

    { const Params P = ldp(kp); convert_weights((LAS float*)lds, P); }
    { const Params P = ldp(kp); row_pass(P, 0, 0.f, nullptr, P.norm_gains, -1); }
    grid.sync();

#pragma unroll 1
    for (int step = 0; step < 12; ++step) {
        const int layer = step / 3, sub = step % 3, jm = layer >> 1;
        if (sub != 1) {
            const Params P = ldp(kp); const int l = layer * 2 + (sub >> 1);
            pg8::Gemm g{(const bf16_t*)(P.ws + WS_HN), (const bf16_t*)(P.ws + WS_WGU + l * SZ_WGU), D, D, D, 0}; pg8::StaticOrder S; S.init(T, 2 * FF, gridDim.x, blockIdx.x);
            pg8::EpiSwiGLU E{(bf16_t*)(P.ws + WS_H), FF}; pg8::gemm_phase(lds, g, S, E);
        } else if ((layer & 1) == 0) {
            const Params P = ldp(kp); pool_pass(P, jm);
        } else {
            {   const Params P = ldp(kp);
                pg8::Gemm g{(const bf16_t*)(P.ws + WS_HN), (const bf16_t*)(P.ws + WS_WIN + jm * SZ_WIN), D, D, D, 0}; pg8::StaticOrder S; S.init(T, IN_PAD, gridDim.x, blockIdx.x);
                pg8::EpiBf16 E{(bf16_t*)(P.ws + WS_PROJ), IN_PAD}; pg8::gemm_phase(lds, g, S, E); }
            grid.sync();
            { const Params P = ldp(kp); delta_phase((LAS float*)lds, P, jm); }
        }
        grid.sync();
        {   const Params P = ldp(kp);
            pg8::Gemm gf; const float* fscale = nullptr; const bf16_t* A = (const bf16_t*)(P.ws + WS_H);
            if (sub != 1) { const int l = layer * 2 + (sub >> 1); gf = pg8::Gemm{A, (const bf16_t*)(P.ws + WS_WDN + l * SZ_WDN), FF, FF, FF, 0}; }
            else if ((layer & 1) == 0) { gf = pg8::Gemm{A, (const bf16_t*)(P.ws + WS_WPOOL + jm * SZ_WPOOL), 256, D, 256, 256}; fscale = P.pool_scale + jm * D; }
            else gf = pg8::Gemm{A, (const bf16_t*)(P.ws + WS_WOUT + jm * SZ_WOUT), VAL_DIM, VAL_DIM, VAL_DIM, 0};
            pg8::StaticOrder S; S.init(T, D, gridDim.x, blockIdx.x); pg8::EpiF32 E{(float*)(P.ws + WS_Y), D, fscale}; pg8::gemm_phase(lds, gf, S, E); }
        grid.sync();
        {   const Params P = ldp(kp); const float* ng = P.norm_gains + (size_t)layer * 6 * D;
            const float* gpost = ng + (sub == 0 ? 1 : sub == 1 ? 3 : 5) * D;
            const float* gnext = sub == 0 ? ng + 2 * D : sub == 1 ? ng + 4 * D : (layer < 3 ? ng + 6 * D : nullptr);
            row_pass(P, 1, sub == 1 ? 1.0f : 0.5f, gpost, gnext, (sub == 0 && (layer & 1) == 0) ? jm : -1); }
        if (step < 11) grid.sync();
    }
}

extern "C" void kernel_launch(void* const* d_in, const int* in_sizes, int n_in, void* d_out, int out_size, void* d_ws, size_t ws_size, hipStream_t stream) {
    static int grid = 0;
    if (grid == 0) {
        int dev = 0, cus = 0, per_cu = 0;
        if (ws_size < WS_END || n_in != 17) { fprintf(stderr, "kernel_launch: need %zu bytes of workspace (got %zu), 17 inputs (got %d)\n", (size_t)WS_END, ws_size, n_in); grid = -1; return; }
        if (hipGetDevice(&dev) != hipSuccess || hipDeviceGetAttribute(&cus, hipDeviceAttributeMultiprocessorCount, dev) != hipSuccess) { grid = -1; return; }
        if (hipFuncSetAttribute((const void*)mk_fwd, hipFuncAttributeMaxDynamicSharedMemorySize, LDS_BYTES) != hipSuccess) { fprintf(stderr, "hipFuncSetAttribute failed\n"); grid = -1; return; }
        if (hipOccupancyMaxActiveBlocksPerMultiprocessor(&per_cu, (const void*)mk_fwd, NTHREADS, LDS_BYTES) != hipSuccess || per_cu < 1) { fprintf(stderr, "occupancy query: %d\n", per_cu); }
        (void)hipGetLastError();
        grid = cus;
    }
    if (grid < 0) return;
    Params p{};
    p.x_prompt = (const float*)d_in[0]; p.x_sample = (const float*)d_in[1]; p.state_pool = (const float*)d_in[2]; p.state_conv = (const float*)d_in[3]; p.state_delta = (const float*)d_in[4];
    p.norm_gains = (const float*)d_in[5]; p.w_gate = (const float*)d_in[6]; p.w_up = (const float*)d_in[7]; p.w_down = (const float*)d_in[8]; p.pool_w = (const float*)d_in[9];
    p.pool_scale = (const float*)d_in[10]; p.dn_w_in = (const float*)d_in[11]; p.dn_conv_w = (const float*)d_in[12]; p.dn_a_log = (const float*)d_in[13]; p.dn_dt_bias = (const float*)d_in[14];
    p.dn_norm_w = (const float*)d_in[15]; p.dn_w_out = (const float*)d_in[16];
    p.out = (float*)d_out; p.ws = (unsigned char*)d_ws;
    void* args[] = {&p};
    hipError_t e = hipLaunchCooperativeKernel((const void*)mk_fwd, dim3(grid), dim3(NTHREADS), args, LDS_BYTES, stream);
    if (e != hipSuccess) fprintf(stderr, "cooperative launch failed: %s (grid %d)\n", hipGetErrorString(e), grid);
}
```

```cpp
#include <hip/hip_runtime.h>
#include <hip/hip_cooperative_groups.h>
#include <cstdio>
namespace cg = cooperative_groups;

#define LAS __attribute__((address_space(3)))
typedef unsigned short bf16_t;
typedef short bf16x8 __attribute__((ext_vector_type(8)));
typedef float f32x4 __attribute__((ext_vector_type(4)));
typedef float f32x2 __attribute__((ext_vector_type(2)));
typedef unsigned u32x4 __attribute__((ext_vector_type(4)));
typedef unsigned u32x2 __attribute__((ext_vector_type(2)));

constexpr int D = 1024, FF = 2816, SEQ = 2048, NB = 8, DB = 128, DS = 4;
constexpr int TP = NB * SEQ, TS = DB * DS, T = TP + TS;
constexpr int CONV_DIM = 4096, IN_DIM = 6176, IN_PAD = 6400, VAL_DIM = 2048, HV = 16;
constexpr float EPS = 1e-6f;
constexpr int NTHREADS = 512;
constexpr int LDS_BYTES = 132 * 1024;

constexpr size_t SZ_WGU = (size_t)2 * FF * D * 2, SZ_WDN = (size_t)D * FF * 2, SZ_WIN = (size_t)IN_PAD * D * 2, SZ_WOUT = (size_t)D * VAL_DIM * 2, SZ_WPOOL = (size_t)D * 256 * 2;
constexpr size_t WS_WGU = 0;
constexpr size_t WS_WDN = WS_WGU + 8 * SZ_WGU;
constexpr size_t WS_WIN = WS_WDN + 8 * SZ_WDN;
constexpr size_t WS_WOUT = WS_WIN + 2 * SZ_WIN;
constexpr size_t WS_WPOOL = WS_WOUT + 2 * SZ_WOUT;
constexpr size_t WS_HN = WS_WPOOL + 2 * SZ_WPOOL;
constexpr size_t WS_H = WS_HN + (size_t)T * D * 2;
constexpr size_t WS_Y = WS_H + (size_t)T * FF * 2;
constexpr size_t WS_PROJ = WS_Y + (size_t)T * D * 4;
constexpr size_t WS_END = WS_PROJ + (size_t)T * IN_PAD * 2;

constexpr size_t O_Y = 0;
constexpr size_t O_POOLP = (size_t)T * D;
constexpr size_t O_CONVP = O_POOLP + (size_t)2 * NB * 15 * D;
constexpr size_t O_DELTAP = O_CONVP + (size_t)2 * NB * 3 * CONV_DIM;
constexpr size_t O_POOLS = O_DELTAP + (size_t)2 * NB * HV * 16384;
constexpr size_t O_CONVS = O_POOLS + (size_t)2 * DB * 15 * D;
constexpr size_t O_DELTAS = O_CONVS + (size_t)2 * DB * 3 * CONV_DIM;

struct Params {
    const float* x_prompt; const float* x_sample; const float* state_pool; const float* state_conv; const float* state_delta; const float* norm_gains;
    const float* w_gate; const float* w_up; const float* w_down; const float* pool_w; const float* pool_scale; const float* dn_w_in; const float* dn_conv_w;
    const float* dn_a_log; const float* dn_dt_bias; const float* dn_norm_w; const float* dn_w_out;
    float* out; unsigned char* ws;
};

__device__ __forceinline__ unsigned cvt_pk_bf16(float lo, float hi) { unsigned r; asm volatile("v_cvt_pk_bf16_f32 %0, %1, %2" : "=v"(r) : "v"(lo), "v"(hi)); return r; }
__device__ __forceinline__ float bf2f(bf16_t b) { return __uint_as_float(((unsigned)b) << 16); }
__device__ __forceinline__ float bflo(unsigned w) { return __uint_as_float(w << 16); }
__device__ __forceinline__ float bfhi(unsigned w) { return __uint_as_float(w & 0xffff0000u); }
__device__ __forceinline__ float silu_f(float x) { return x * __builtin_amdgcn_rcpf(1.0f + __builtin_amdgcn_exp2f(-1.44269504089f * x)); }
__device__ __forceinline__ float wave_sum(float v) {
#pragma unroll
    for (int o = 32; o >= 1; o >>= 1) v += __shfl_xor(v, o);
    return v;
}
__device__ __forceinline__ int opaque_tid() { int t = threadIdx.x; asm volatile("" : "+v"(t)); return t; }
template <int CTRL> __device__ __forceinline__ float dppf(float x) { return __builtin_bit_cast(float, __builtin_amdgcn_mov_dpp(__builtin_bit_cast(int, x), CTRL, 0xf, 0xf, true)); }
__device__ __forceinline__ float red8(float x) { x += dppf<0xB1>(x); x += dppf<0x4E>(x); x += dppf<0x141>(x); return x; }

namespace pg8 {
constexpr int BM = 256, BK = 64, HALF = 128, HTB = HALF * BK * 2, STAGE_BYTES = 8 * HTB, NXCD = 8, WGM = 8;
__device__ __forceinline__ int lds_byte(int r, int c) { const int st = (r >> 4) * 2 + (c >> 5), rr = r & 15, cc = c & 31, ob = rr * 64 + cc * 2; return st * 1024 + (ob ^ (((ob >> 9) & 1) << 5)); }
__device__ __forceinline__ void stage_rc(int b, int& R, int& C) { const int st = b / 1024, sb = b % 1024, swz = sb ^ (((sb >> 9) & 1) << 5); R = (st >> 1) * 16 + swz / 64; C = (st & 1) * 32 + (swz % 64) / 2; }
__device__ __forceinline__ int perm32(int rho) { const int n = rho >> 4, i = rho & 15; return 8 * (i >> 2) + 4 * n + (i & 3); }

struct Unit { int pm, pn; };
struct Gemm { const bf16_t* A; const bf16_t* Bt; int K, lda, ldb, acol; };

struct StaticOrder {
    int nM, nN, nwg, G, c;
    __device__ void init(int M, int N, int G_, int c_) { nM = M / BM; nN = N / BM; nwg = nM * nN; G = G_; c = c_; }
    __device__ bool next(int i, Unit& u) const {
        const long L = (long)i * G + c; if (L >= nwg) return false;
        int wgid = (int)L; { const int q = nwg / NXCD, r = nwg % NXCD, xcd = wgid % NXCD, off = wgid / NXCD; wgid = (xcd < r ? xcd * (q + 1) : r * (q + 1) + (xcd - r) * q) + off; }
        const int nig = WGM * nN, gid = wgid / nig, fm = gid * WGM, gsz = (nM - fm) < WGM ? (nM - fm) : WGM;
        u.pm = fm + ((wgid % nig) % gsz); u.pn = (wgid % nig) / gsz; return true;
    }
};

struct EpiF32 {
    static constexpr bool PERM = false;
    float* C; int ldc; const float* scale;
    __device__ __forceinline__ void operator()(const f32x4 (&acc)[2][2][4][2], const Unit& u, int wr, int wc, int fr, int fq) const {
        const int row0 = u.pm * BM + wr * 64 + fr, col0 = u.pn * BM + wc * 32 + 4 * fq;
        f32x4 sv[2][2];
#pragma unroll
        for (int bj = 0; bj < 2; ++bj)
#pragma unroll
            for (int n = 0; n < 2; ++n) sv[bj][n] = scale ? *(const f32x4*)(scale + col0 + bj * HALF + n * 16) : (f32x4){1.f, 1.f, 1.f, 1.f};
#pragma unroll
        for (int ai = 0; ai < 2; ++ai)
#pragma unroll
            for (int m = 0; m < 4; ++m) { float* rowp = C + (size_t)(row0 + ai * HALF + m * 16) * ldc + col0;
#pragma unroll
                for (int bj = 0; bj < 2; ++bj)
#pragma unroll
                    for (int n = 0; n < 2; ++n) *(f32x4*)(rowp + bj * HALF + n * 16) = acc[ai][bj][m][n] * sv[bj][n]; }
    }
};
struct EpiBf16 {
    static constexpr bool PERM = true;
    bf16_t* O; int ldc;
    __device__ __forceinline__ void operator()(const f32x4 (&acc)[2][2][4][2], const Unit& u, int wr, int wc, int fr, int fq) const {
        const int row0 = u.pm * BM + wr * 64 + fr, col0 = u.pn * BM + wc * 32 + 8 * fq;
#pragma unroll
        for (int ai = 0; ai < 2; ++ai)
#pragma unroll
            for (int m = 0; m < 4; ++m) { bf16_t* rowp = O + (size_t)(row0 + ai * HALF + m * 16) * ldc + col0;
#pragma unroll
                for (int bj = 0; bj < 2; ++bj) { const f32x4 v0 = acc[ai][bj][m][0], v1 = acc[ai][bj][m][1];
                    u32x4 w; w.x = cvt_pk_bf16(v0[0], v0[1]); w.y = cvt_pk_bf16(v0[2], v0[3]); w.z = cvt_pk_bf16(v1[0], v1[1]); w.w = cvt_pk_bf16(v1[2], v1[3]);
                    *(u32x4*)(rowp + bj * HALF) = w; } }
    }
};
struct EpiSwiGLU {
    static constexpr bool PERM = true;
    bf16_t* O; int ldc;
    __device__ __forceinline__ void operator()(const f32x4 (&acc)[2][2][4][2], const Unit& u, int wr, int wc, int fr, int fq) const {
        const int row0 = u.pm * BM + wr * 64 + fr, col0 = u.pn * HALF + wc * 32 + 8 * fq;
#pragma unroll
        for (int ai = 0; ai < 2; ++ai)
#pragma unroll
            for (int m = 0; m < 4; ++m) { bf16_t* rowp = O + (size_t)(row0 + ai * HALF + m * 16) * ldc + col0;
                const f32x4 g0 = acc[ai][0][m][0], g1 = acc[ai][0][m][1], u0 = acc[ai][1][m][0], u1 = acc[ai][1][m][1];
                u32x4 w; w.x = cvt_pk_bf16(silu_f(g0[0]) * u0[0], silu_f(g0[1]) * u0[1]); w.y = cvt_pk_bf16(silu_f(g0[2]) * u0[2], silu_f(g0[3]) * u0[3]);
                w.z = cvt_pk_bf16(silu_f(g1[0]) * u1[0], silu_f(g1[1]) * u1[1]); w.w = cvt_pk_bf16(silu_f(g1[2]) * u1[2], silu_f(g1[3]) * u1[3]);
                *(u32x4*)rowp = w; }
    }
};

template <class Epi, class Sched>
__device__ __forceinline__ void gemm_phase(LAS unsigned char* lds, const Gemm g, const Sched& S, const Epi& E) {
    const int tid = opaque_tid(), wid = __builtin_amdgcn_readfirstlane(tid >> 6), lane = tid & 63, wr = wid >> 2, wc = wid & 3, fr = lane & 15, fq = lane >> 4;
    const int K = g.K, nt = K / BK;
    unsigned voffA[2], voffB[2];
#pragma unroll
    for (int i = 0; i < 2; ++i) { int R, C; stage_rc(tid * 16 + i * 8192, R, C); const int Rb = Epi::PERM ? ((R & ~31) + perm32(R & 31)) : R;
        voffA[i] = (unsigned)(R * g.lda + C) * 2u; voffB[i] = (unsigned)(Rb * g.ldb + C) * 2u; }
    const size_t kstep = (size_t)(BK * 2);
    const size_t hstepA = (size_t)HALF * g.lda * 2, hstepB = (size_t)HALF * g.ldb * 2;
    const size_t tstepA = 2 * hstepA, tstepB = 2 * hstepB;
    const unsigned ldsw = (unsigned)wid * 1024u;
    const int aoff = lds_byte(wr * 64 + fr, fq * 8), boff = lds_byte(wc * 32 + fr, fq * 8);
#define PG8_SA(b, h) (((b) * 2 + (h)) * HTB)
#define PG8_SB(b, h) ((4 + (b) * 2 + (h)) * HTB)
#define PG8_STAGE(bufoff, gbase, voff) do { _Pragma("unroll") for (int _i = 0; _i < 2; ++_i) \
        __builtin_amdgcn_global_load_lds((const unsigned*)((const char*)(gbase) + (voff)[_i]), (LAS unsigned*)(lds + (bufoff) + ldsw + _i * 8192), 16, 0, 0); } while (0)
#define PG8_LDA(dst, b, h) do { _Pragma("unroll") for (int m = 0; m < 4; ++m) _Pragma("unroll") for (int k = 0; k < 2; ++k) dst[m][k] = *(const LAS bf16x8*)(lds + PG8_SA(b, h) + aoff + m * 2048 + k * 1024); } while (0)
#define PG8_LDB(dst, b, h) do { _Pragma("unroll") for (int n = 0; n < 2; ++n) _Pragma("unroll") for (int k = 0; k < 2; ++k) dst[n][k] = *(const LAS bf16x8*)(lds + PG8_SB(b, h) + boff + n * 2048 + k * 1024); } while (0)
#define PG8_MMA(ai, bj, At, Bt) do { __builtin_amdgcn_s_setprio(1); _Pragma("unroll") for (int m = 0; m < 4; ++m) _Pragma("unroll") for (int n = 0; n < 2; ++n) _Pragma("unroll") for (int k = 0; k < 2; ++k) \
        acc[ai][bj][m][n] = __builtin_amdgcn_mfma_f32_16x16x32_bf16(Bt[n][k], At[m][k], acc[ai][bj][m][n], 0, 0, 0); __builtin_amdgcn_s_setprio(0); } while (0)
#define PG8_WAIT_V(n) asm volatile("s_waitcnt vmcnt(" #n ")" ::: "memory")
#define PG8_WAIT_L(n) asm volatile("s_waitcnt lgkmcnt(" #n ")" ::: "memory")
#define PG8_BAR __builtin_amdgcn_s_barrier()
#define PG8_SCHED __builtin_amdgcn_sched_barrier(0)
    Unit cur, nxt; int ui = 0;
    if (!S.next(0, cur)) return;
    f32x4 acc[2][2][4][2];
#pragma unroll
    for (int a = 0; a < 2; ++a)
#pragma unroll
        for (int b = 0; b < 2; ++b)
#pragma unroll
            for (int m = 0; m < 4; ++m)
#pragma unroll
                for (int n = 0; n < 2; ++n) acc[a][b][m][n] = (f32x4){0.f, 0.f, 0.f, 0.f};
    bf16x8 At[4][2], B0[2][2], B1[2][2];
    const char* cA = (const char*)g.A + (size_t)cur.pm * tstepA + (size_t)cur.pn * g.acol * 2; const char* cB = (const char*)g.Bt + (size_t)cur.pn * tstepB;
    PG8_STAGE(PG8_SB(0, 0), cB, voffB); PG8_STAGE(PG8_SA(0, 0), cA, voffA); PG8_STAGE(PG8_SB(0, 1), cB + hstepB, voffB); PG8_STAGE(PG8_SA(0, 1), cA + hstepA, voffA);
    if (wr == 1) PG8_BAR;
    PG8_WAIT_V(4); PG8_BAR;
    PG8_STAGE(PG8_SB(1, 0), cB + kstep, voffB); PG8_STAGE(PG8_SA(1, 0), cA + kstep, voffA); PG8_STAGE(PG8_SB(1, 1), cB + hstepB + kstep, voffB);
    PG8_WAIT_V(6); PG8_BAR;
    for (;;) {
        const bool has_next = S.next(ui + 1, nxt);
        const char* nA = has_next ? (const char*)g.A + (size_t)nxt.pm * tstepA + (size_t)nxt.pn * g.acol * 2 : cA; const char* nB = has_next ? (const char*)g.Bt + (size_t)nxt.pn * tstepB : cB;
        for (int t = 0; t < nt; t += 2) {
            const bool last = (t == nt - 2);
            const char* a1 = cA + (size_t)(t + 1) * kstep;
            const char* a2 = last ? nA : cA + (size_t)(t + 2) * kstep; const char* b2 = last ? nB : cB + (size_t)(t + 2) * kstep;
            const char* a3 = a2 + kstep; const char* b3 = b2 + kstep;
            PG8_LDB(B0, 0, 0); PG8_SCHED; PG8_LDA(At, 0, 0); PG8_STAGE(PG8_SA(1, 1), a1 + hstepA, voffA);
            PG8_WAIT_L(8); PG8_BAR; PG8_WAIT_L(0); PG8_MMA(0, 0, At, B0); PG8_BAR; PG8_SCHED;
            PG8_LDB(B1, 0, 1); PG8_STAGE(PG8_SB(0, 0), b2, voffB);
            PG8_BAR; PG8_WAIT_L(0); PG8_MMA(0, 1, At, B1); PG8_BAR;
            PG8_LDA(At, 0, 1); PG8_STAGE(PG8_SA(0, 0), a2, voffA);
            PG8_BAR; PG8_WAIT_L(0); PG8_MMA(1, 0, At, B0); PG8_BAR; PG8_SCHED;
            PG8_STAGE(PG8_SB(0, 1), b2 + hstepB, voffB);
            PG8_WAIT_V(6); PG8_BAR; PG8_MMA(1, 1, At, B1); PG8_BAR;
            PG8_LDB(B0, 1, 0); PG8_SCHED; PG8_LDA(At, 1, 0); PG8_STAGE(PG8_SA(0, 1), a2 + hstepA, voffA);
            PG8_WAIT_L(8); PG8_BAR; PG8_WAIT_L(0); PG8_MMA(0, 0, At, B0); PG8_BAR; PG8_SCHED;
            PG8_LDB(B1, 1, 1); PG8_STAGE(PG8_SB(1, 0), b3, voffB);
            PG8_BAR; PG8_WAIT_L(0); PG8_MMA(0, 1, At, B1); PG8_BAR;
            PG8_LDA(At, 1, 1); PG8_STAGE(PG8_SA(1, 0), a3, voffA);
            PG8_BAR; PG8_WAIT_L(0); PG8_MMA(1, 0, At, B0); PG8_BAR; PG8_SCHED;
            PG8_STAGE(PG8_SB(1, 1), b3 + hstepB, voffB);
            PG8_WAIT_V(6); PG8_BAR; PG8_MMA(1, 1, At, B1); PG8_BAR;
        }
        E(acc, cur, wr, wc, fr, fq);
        if (!has_next) break;
#pragma unroll
        for (int a = 0; a < 2; ++a)
#pragma unroll
            for (int b = 0; b < 2; ++b)
#pragma unroll
                for (int m = 0; m < 4; ++m)
#pragma unroll
                    for (int n = 0; n < 2; ++n) acc[a][b][m][n] = (f32x4){0.f, 0.f, 0.f, 0.f};
        cur = nxt; cA = nA; cB = nB; ++ui;
    }
    PG8_WAIT_V(0);
    if (wr == 0) PG8_BAR;
    PG8_BAR;
#undef PG8_SA
#undef PG8_SB
#undef PG8_STAGE
#undef PG8_LDA
#undef PG8_LDB
#undef PG8_MMA
#undef PG8_WAIT_V
#undef PG8_WAIT_L
#undef PG8_BAR
#undef PG8_SCHED
}
}

constexpr int CT_GU = 8 * 16 * 88, CT_DN = 8 * 44 * 16, CT_IN = 2 * 16 * 100, CT_OUT = 2 * 32 * 16, CT_POOL = 8 * 4 * 4;
constexpr int CT_TOTAL = CT_GU + CT_DN + CT_IN + CT_OUT + CT_POOL;

__device__ __forceinline__ void convert_weights(LAS float* tile, const Params& P) {
    const int tid = opaque_tid();
    for (int t = blockIdx.x; t < CT_TOTAL; t += gridDim.x) {
        const float* src; int ldsrc, k0, n0, nvalid, lddst, dstrow0; bf16_t* dst;
        if (t < CT_GU) { const int l = t / 1408, rem = t % 1408, kt = rem % 16, rt = rem / 16, r0 = rt * 64, pn = r0 >> 8, bj = (r0 >> 7) & 1, j0 = r0 & 127;
            src = (bj ? P.w_up : P.w_gate) + (size_t)l * D * FF; ldsrc = FF; k0 = kt * 64; n0 = 128 * pn + j0; nvalid = FF; dst = (bf16_t*)(P.ws + WS_WGU + l * SZ_WGU); lddst = D; dstrow0 = r0; }
        else if (t < CT_GU + CT_DN) { const int tt = t - CT_GU, l = tt / 704, rem = tt % 704, kt = rem % 44, nt_ = rem / 44;
            src = P.w_down + (size_t)l * FF * D; ldsrc = D; k0 = kt * 64; n0 = nt_ * 64; nvalid = D; dst = (bf16_t*)(P.ws + WS_WDN + l * SZ_WDN); lddst = FF; dstrow0 = n0; }
        else if (t < CT_GU + CT_DN + CT_IN) { const int tt = t - CT_GU - CT_DN, l = tt / 1600, rem = tt % 1600, kt = rem % 16, nt_ = rem / 16;
            src = P.dn_w_in + (size_t)l * D * IN_DIM; ldsrc = IN_DIM; k0 = kt * 64; n0 = nt_ * 64; nvalid = IN_DIM; dst = (bf16_t*)(P.ws + WS_WIN + l * SZ_WIN); lddst = D; dstrow0 = n0; }
        else if (t < CT_GU + CT_DN + CT_IN + CT_OUT) { const int tt = t - CT_GU - CT_DN - CT_IN, l = tt / 512, rem = tt % 512, kt = rem % 32, nt_ = rem / 32;
            src = P.dn_w_out + (size_t)l * VAL_DIM * D; ldsrc = D; k0 = kt * 64; n0 = nt_ * 64; nvalid = D; dst = (bf16_t*)(P.ws + WS_WOUT + l * SZ_WOUT); lddst = VAL_DIM; dstrow0 = n0; }
        else { const int tt = t - CT_GU - CT_DN - CT_IN - CT_OUT, mtx = tt / 16, rem = tt % 16, kt = rem % 4, nt_ = rem / 4;
            src = P.pool_w + (size_t)mtx * 65536; ldsrc = 256; k0 = kt * 64; n0 = nt_ * 64; nvalid = 256; dst = (bf16_t*)(P.ws + WS_WPOOL) + (size_t)mtx * 65536; lddst = 256; dstrow0 = n0; }
        {   const int rr = tid >> 4, c4 = tid & 15, n = n0 + c4 * 4;
#pragma unroll
            for (int h = 0; h < 2; ++h) { const int k = rr + h * 32;
                f32x4 v = (f32x4){0.f, 0.f, 0.f, 0.f};
                if (n < nvalid) v = *(const f32x4*)(src + (size_t)(k0 + k) * ldsrc + n);
                LAS float* tp = tile + k * 65 + c4 * 4; tp[0] = v[0]; tp[1] = v[1]; tp[2] = v[2]; tp[3] = v[3]; }
        }
        __syncthreads();
        {   const int n = tid >> 3, kg = tid & 7; const LAS float* tp = tile + (kg * 8) * 65 + n;
            u32x4 w; w.x = cvt_pk_bf16(tp[0], tp[65]); w.y = cvt_pk_bf16(tp[130], tp[195]); w.z = cvt_pk_bf16(tp[260], tp[325]); w.w = cvt_pk_bf16(tp[390], tp[455]);
            *(u32x4*)(dst + (size_t)(dstrow0 + n) * lddst + k0 + kg * 8) = w;
        }
        __syncthreads();
    }
}

__device__ __forceinline__ void row_pass(const Params& P, int mode, float coef, const float* gpost, const float* gnext, int pool_j) {
    const int tid = opaque_tid(), lane = tid & 63, wv = tid >> 6;
    float* X = P.out + O_Y; const float* Y = (const float*)(P.ws + WS_Y); bf16_t* HN = (bf16_t*)(P.ws + WS_HN);
    for (int row = blockIdx.x * 8 + wv; row < T; row += gridDim.x * 8) {
        f32x4 x[4];
        if (mode == 0) { const float* src = row < TP ? P.x_prompt + (size_t)row * D : P.x_sample + (size_t)(row - TP) * D;
#pragma unroll
            for (int i = 0; i < 4; ++i) x[i] = *(const f32x4*)(src + i * 256 + lane * 4); }
        else { f32x4 y[4]; float ss = 0.f;
#pragma unroll
            for (int i = 0; i < 4; ++i) { y[i] = *(const f32x4*)(Y + (size_t)row * D + i * 256 + lane * 4); x[i] = *(const f32x4*)(X + (size_t)row * D + i * 256 + lane * 4);
                ss += y[i][0] * y[i][0] + y[i][1] * y[i][1] + y[i][2] * y[i][2] + y[i][3] * y[i][3]; }
            ss = wave_sum(ss); const float r = coef * __builtin_amdgcn_rsqf(ss * (1.0f / D) + EPS);
#pragma unroll
            for (int i = 0; i < 4; ++i) { const f32x4 gp = *(const f32x4*)(gpost + i * 256 + lane * 4); x[i] += y[i] * gp * r; } }
#pragma unroll
        for (int i = 0; i < 4; ++i) *(f32x4*)(X + (size_t)row * D + i * 256 + lane * 4) = x[i];
        if (gnext) { float ss = 0.f;
#pragma unroll
            for (int i = 0; i < 4; ++i) ss += x[i][0] * x[i][0] + x[i][1] * x[i][1] + x[i][2] * x[i][2] + x[i][3] * x[i][3];
            ss = wave_sum(ss); const float r = __builtin_amdgcn_rsqf(ss * (1.0f / D) + EPS);
            float* pdst = nullptr;
            if (pool_j >= 0) { if (row < TP) { const int b = row / SEQ, s = row % SEQ; if (s >= SEQ - 15) pdst = P.out + O_POOLP + ((size_t)(pool_j * NB + b) * 15 + (s - (SEQ - 15))) * D; }
                               else { const int b = (row - TP) / DS, s = (row - TP) % DS; pdst = P.out + O_POOLS + ((size_t)(pool_j * DB + b) * 15 + 11 + s) * D; } }
#pragma unroll
            for (int i = 0; i < 4; ++i) { const f32x4 gn = *(const f32x4*)(gnext + i * 256 + lane * 4); const f32x4 h = x[i] * gn * r;
                u32x2 w; w.x = cvt_pk_bf16(h[0], h[1]); w.y = cvt_pk_bf16(h[2], h[3]); *(u32x2*)(HN + (size_t)row * D + i * 256 + lane * 4) = w;
                if (pdst) *(f32x4*)(pdst + i * 256 + lane * 4) = h; } }
    }
}

__device__ __forceinline__ void pool_pass(const Params& P, int j) {
    const bf16_t* HN = (const bf16_t*)(P.ws + WS_HN); bf16_t* PO = (bf16_t*)(P.ws + WS_H);
    const float* past = P.state_pool + (size_t)j * DB * 15 * D;
    const size_t gtid = (size_t)blockIdx.x * NTHREADS + opaque_tid(), gsz = (size_t)gridDim.x * NTHREADS;
    for (size_t it = gtid; it < (size_t)T * 128; it += gsz) {
        const int row = (int)(it >> 7), ch = (int)(it & 127), col = ch * 8, w = 2 << (ch >> 5);
        float a[8];
#pragma unroll
        for (int q = 0; q < 8; ++q) a[q] = 0.f;
        const u32x4 self = *(const u32x4*)(HN + (size_t)row * D + col);
        float cnt;
        if (row < TP) { const int s = row % SEQ; const int n = (s + 1 < w) ? s + 1 : w; cnt = (float)n;
            for (int i = 0; i < n; ++i) { const u32x4 v = *(const u32x4*)(HN + (size_t)(row - i) * D + col);
                a[0] += bflo(v.x); a[1] += bfhi(v.x); a[2] += bflo(v.y); a[3] += bfhi(v.y); a[4] += bflo(v.z); a[5] += bfhi(v.z); a[6] += bflo(v.w); a[7] += bfhi(v.w); } }
        else { const int b = (row - TP) / DS, s = (row - TP) % DS; cnt = (float)w;
            for (int i = 0; i < w; ++i) {
                if (s - i >= 0) { const u32x4 v = *(const u32x4*)(HN + (size_t)(row - i) * D + col);
                    a[0] += bflo(v.x); a[1] += bfhi(v.x); a[2] += bflo(v.y); a[3] += bfhi(v.y); a[4] += bflo(v.z); a[5] += bfhi(v.z); a[6] += bflo(v.w); a[7] += bfhi(v.w); }
                else { const float* pp = past + ((size_t)b * 15 + (15 + s - i)) * D + col; const f32x4 v0 = *(const f32x4*)pp, v1 = *(const f32x4*)(pp + 4);
                    a[0] += v0[0]; a[1] += v0[1]; a[2] += v0[2]; a[3] += v0[3]; a[4] += v1[0]; a[5] += v1[1]; a[6] += v1[2]; a[7] += v1[3]; } } }
        const float ic = 1.0f / cnt;
        u32x4 o; o.x = cvt_pk_bf16(a[0] * ic - bflo(self.x), a[1] * ic - bfhi(self.x)); o.y = cvt_pk_bf16(a[2] * ic - bflo(self.y), a[3] * ic - bfhi(self.y));
        o.z = cvt_pk_bf16(a[4] * ic - bflo(self.z), a[5] * ic - bfhi(self.z)); o.w = cvt_pk_bf16(a[6] * ic - bflo(self.w), a[7] * ic - bfhi(self.w));
        *(u32x4*)(PO + (size_t)row * D + col) = o;
    }
    float* dst = P.out + O_POOLS + (size_t)j * DB * 15 * D;
    for (size_t it = gtid; it < (size_t)DB * 11 * (D / 4); it += gsz) { const int b = (int)(it / (11 * 256)), r = (int)(it % (11 * 256)), p = r / 256, c4 = r % 256;
        *(f32x4*)(dst + ((size_t)b * 15 + p) * D + c4 * 4) = *(const f32x4*)(past + ((size_t)b * 15 + p + 4) * D + c4 * 4); }
}

constexpr int TB = 32;
constexpr int L_QS = 0, L_KS = 16384, L_VS = 32768, L_OS = 49152, L_GBK = 65536, L_CW = 66048, L_RAW = 72192, L_Z = 99072, L_BA = 107264;
constexpr int RAW_PIECES = (TB + 3) * 48;
__device__ __forceinline__ int seg_col(int seg, int hk, int hv) { return seg == 0 ? hk * 128 : (seg == 1 ? 1024 + hk * 128 : 2048 + hv * 128); }
__device__ __forceinline__ void delta_fetch(const bf16_t* proj, const float* cpast, bool isPrompt, int row0, int ntok, int t0, int hk, int hv, int tid, u32x4 (&rr)[4], u32x4& rz, unsigned& rba) {
#pragma unroll
    for (int i = 0; i < 4; ++i) { const int p = tid + NTHREADS * i; rr[i] = (u32x4){0u, 0u, 0u, 0u};
        if (p < RAW_PIECES) { const int r = p / 48, q48 = p % 48, seg = q48 >> 4, l16 = q48 & 15, tt = t0 - 3 + r, col = seg_col(seg, hk, hv) + l16 * 8;
            if (tt >= 0) { if (tt < ntok) rr[i] = *(const u32x4*)(proj + (size_t)(row0 + tt) * IN_PAD + col); }
            else if (!isPrompt) { const float* f = cpast + (3 + tt) * CONV_DIM + col; const f32x4 a = *(const f32x4*)f, c = *(const f32x4*)(f + 4);
                rr[i] = (u32x4){cvt_pk_bf16(a[0], a[1]), cvt_pk_bf16(a[2], a[3]), cvt_pk_bf16(c[0], c[1]), cvt_pk_bf16(c[2], c[3])}; } } }
    {   const int r = tid >> 4, l16 = tid & 15, tt = t0 + r; rz = (u32x4){0u, 0u, 0u, 0u};
        if (tt < ntok) rz = *(const u32x4*)(proj + (size_t)(row0 + tt) * IN_PAD + 4096 + hv * 128 + l16 * 8); }
    rba = 0u;
    if (tid < 2 * TB) { const int r = tid >> 1, tt = t0 + r; if (tt < ntok) rba = proj[(size_t)(row0 + tt) * IN_PAD + 6144 + (tid & 1) * 16 + hv]; }
}
__device__ __forceinline__ void delta_item(LAS unsigned char* LB, const Params& P, int j, bool isPrompt, int b, int hv) {
    const int tid = opaque_tid(), lane = tid & 63, wv = tid >> 6, dg = lane & 7, ep = lane >> 3, ecol = 16 * wv + 2 * ep, hk = hv >> 1;
    LAS float* L = (LAS float*)LB; LAS float* qs = (LAS float*)(LB + L_QS); LAS float* ks = (LAS float*)(LB + L_KS); LAS float* vs = (LAS float*)(LB + L_VS); LAS float* os = (LAS float*)(LB + L_OS);
    LAS float* gbk = (LAS float*)(LB + L_GBK); LAS float* cw = (LAS float*)(LB + L_CW); LAS bf16_t* raw = (LAS bf16_t*)(LB + L_RAW); LAS bf16_t* zr = (LAS bf16_t*)(LB + L_Z); LAS bf16_t* ba = (LAS bf16_t*)(LB + L_BA);
    const bf16_t* proj = (const bf16_t*)(P.ws + WS_PROJ); bf16_t* OG = (bf16_t*)(P.ws + WS_H);
    const float* conv_w = P.dn_conv_w + (size_t)j * 4 * CONV_DIM; const float* normw = P.dn_norm_w + j * 128;
    const float alog = P.dn_a_log[j * HV + hv], dtb = P.dn_dt_bias[j * HV + hv];
    const int row0 = isPrompt ? b * SEQ : TP + b * DS, ntok = isPrompt ? SEQ : DS;
    const float* cpast = P.state_conv + (size_t)(j * DB + b) * 3 * CONV_DIM;
    u32x4 rr[4], rz; unsigned rba;
    delta_fetch(proj, cpast, isPrompt, row0, ntok, 0, hk, hv, tid, rr, rz, rba);
    for (int idx = tid; idx < 4 * 384; idx += NTHREADS) { const int jj = idx / 384, ch = idx % 384; cw[idx] = conv_w[jj * CONV_DIM + seg_col(ch >> 7, hk, hv) + (ch & 127)]; }
    f32x2 s[16];
    if (isPrompt) {
#pragma unroll
        for (int i = 0; i < 16; ++i) s[i] = (f32x2){0.f, 0.f}; }
    else { const float* s0 = P.state_delta + ((size_t)(j * DB + b) * HV + hv) * 16384;
#pragma unroll
        for (int i = 0; i < 16; ++i) s[i] = *(const f32x2*)(s0 + (32 * (i >> 2) + 4 * dg + (i & 3)) * 128 + ecol); }
    const f32x2 nw = *(const f32x2*)(normw + lane * 2);
    const float nalog = -__expf(alog);
    float Gacc = 0.f;
    for (int t0 = 0; t0 < ntok; t0 += TB) {
        const int nb = (ntok - t0) < TB ? (ntok - t0) : TB;
#pragma unroll
        for (int i = 0; i < 4; ++i) { const int p = tid + NTHREADS * i; if (p < RAW_PIECES) *(LAS u32x4*)(raw + p * 8) = rr[i]; }
        *(LAS u32x4*)(zr + tid * 8) = rz;
        if (tid < 2 * TB) ba[tid] = (bf16_t)rba;
        __syncthreads();
        if (t0 + TB < ntok) delta_fetch(proj, cpast, isPrompt, row0, ntok, t0 + TB, hk, hv, tid, rr, rz, rba);
        for (int idx = tid; idx < nb * 384; idx += NTHREADS) {
            const int tok = idx / 384, ch = idx % 384;
            float acc = 0.f;
#pragma unroll
            for (int jj = 0; jj < 4; ++jj) acc += bf2f(raw[(tok + jj) * 384 + ch]) * cw[jj * 384 + ch];
            L[(ch >> 7) * TB * 128 + tok * 128 + (ch & 127)] = silu_f(acc);
        }
        if (tid < nb) { const float bb = bf2f(ba[tid * 2]), aa = bf2f(ba[tid * 2 + 1]) + dtb;
            const float sp = aa > 20.f ? aa : log1pf(__expf(aa)); gbk[tid * 4] = nalog * sp; gbk[tid * 4 + 1] = 1.0f / (1.0f + __expf(-bb)); }
        __syncthreads();
        for (int tok = wv; tok < nb; tok += 8) { f32x2 q = *(LAS f32x2*)(qs + tok * 128 + lane * 2), k = *(LAS f32x2*)(ks + tok * 128 + lane * 2);
            const float sq = wave_sum(q.x * q.x + q.y * q.y), sk = wave_sum(k.x * k.x + k.y * k.y);
            const float rq = __builtin_amdgcn_rsqf(sq + EPS) * 0.08838834764831845f, rk = __builtin_amdgcn_rsqf(sk + EPS);
            q *= rq; k *= rk; *(LAS f32x2*)(qs + tok * 128 + lane * 2) = q; *(LAS f32x2*)(ks + tok * 128 + lane * 2) = k;
            const float kq = wave_sum(q.x * k.x + q.y * k.y); if (lane == 0) gbk[tok * 4 + 2] = kq; }
        __syncthreads();
        for (int tok = 0; tok < nb; ++tok) {
            f32x4 kv[4], qv[4];
#pragma unroll
            for (int i = 0; i < 4; ++i) { kv[i] = *(const LAS f32x4*)(ks + tok * 128 + 32 * i + 4 * dg); qv[i] = *(const LAS f32x4*)(qs + tok * 128 + 32 * i + 4 * dg); }
            const f32x2 v = *(const LAS f32x2*)(vs + tok * 128 + ecol);
            const f32x4 gb = *(const LAS f32x4*)(gbk + tok * 4);
            const float g = gb[0], beta = gb[1], kq = gb[2];
            float Gn = Gacc + g;
            if (Gn < -30.f) { const float f = __expf(Gn);
#pragma unroll
                for (int i = 0; i < 16; ++i) s[i] *= f;
                Gn = 0.f; }
            Gacc = Gn;
            f32x2 pp0 = (f32x2){0.f, 0.f}, pp1 = pp0, oo0 = pp0, oo1 = pp0;
#pragma unroll
            for (int i = 0; i < 16; i += 2) { pp0 += s[i] * kv[i >> 2][i & 3]; oo0 += s[i] * qv[i >> 2][i & 3]; pp1 += s[i + 1] * kv[i >> 2][(i & 3) + 1]; oo1 += s[i + 1] * qv[i >> 2][(i & 3) + 1]; }
            f32x2 pp = pp0 + pp1, oo = oo0 + oo1;
            pp.x = red8(pp.x); pp.y = red8(pp.y); oo.x = red8(oo.x); oo.y = red8(oo.y);
            const float c = __expf(Gacc), ic = __expf(-Gacc);
            const f32x2 dl = (v - pp * c) * beta, dt = dl * ic;
#pragma unroll
            for (int i = 0; i < 16; ++i) s[i] += dt * kv[i >> 2][i & 3];
            const f32x2 o = oo * c + dl * kq;
            if (dg == 0) *(LAS f32x2*)(os + tok * 128 + ecol) = o;
        }
        __syncthreads();
        for (int tok = wv; tok < nb; tok += 8) { const f32x2 o = *(const LAS f32x2*)(os + tok * 128 + lane * 2);
            const float ss = wave_sum(o.x * o.x + o.y * o.y), r = __builtin_amdgcn_rsqf(ss * (1.0f / 128.f) + EPS);
            const unsigned zz = *(const LAS unsigned*)(zr + tok * 128 + lane * 2);
            *(unsigned*)(OG + (size_t)(row0 + t0 + tok) * VAL_DIM + hv * 128 + lane * 2) = cvt_pk_bf16(o.x * r * nw.x * silu_f(bflo(zz)), o.y * r * nw.y * silu_f(bfhi(zz))); }
        __syncthreads();
    }
    {   const float c = __expf(Gacc);
        float* sd = isPrompt ? P.out + O_DELTAP + ((size_t)(j * NB + b) * HV + hv) * 16384 : P.out + O_DELTAS + ((size_t)(j * DB + b) * HV + hv) * 16384;
#pragma unroll
        for (int i = 0; i < 16; ++i) *(f32x2*)(sd + (32 * (i >> 2) + 4 * dg + (i & 3)) * 128 + ecol) = s[i] * c; }
}
__device__ __forceinline__ void delta_phase(LAS unsigned char* L, const Params& P, int j) {
    const int G = gridDim.x, bid = blockIdx.x;
    const bf16_t* proj = (const bf16_t*)(P.ws + WS_PROJ);
    {
        const size_t gtid = (size_t)bid * NTHREADS + opaque_tid(), gsz = (size_t)G * NTHREADS;
        for (size_t it = gtid; it < (size_t)NB * 3 * CONV_DIM; it += gsz) { const int b = (int)(it / (3 * CONV_DIM)), r = (int)(it % (3 * CONV_DIM)), p = r / CONV_DIM, c = r % CONV_DIM;
            P.out[O_CONVP + (size_t)j * NB * 3 * CONV_DIM + it] = bf2f(proj[(size_t)(b * SEQ + SEQ - 3 + p) * IN_PAD + c]); }
        for (size_t it = gtid; it < (size_t)DB * 3 * CONV_DIM; it += gsz) { const int b = (int)(it / (3 * CONV_DIM)), r = (int)(it % (3 * CONV_DIM)), p = r / CONV_DIM, c = r % CONV_DIM;
            P.out[O_CONVS + (size_t)j * DB * 3 * CONV_DIM + it] = bf2f(proj[(size_t)(TP + b * DS + 1 + p) * IN_PAD + c]); }
    }
    const int nP = NB * HV, nS = DB * HV;
    if (G >= 2 * nP) {
        if (bid < nP) delta_item(L, P, j, true, bid / HV, bid % HV);
        else for (int it = bid - nP; it < nS; it += G - nP) delta_item(L, P, j, false, it / HV, it % HV);
    } else {
        for (int it = bid; it < nP + nS; it += G) { if (it < nP) delta_item(L, P, j, true, it / HV, it % HV); else delta_item(L, P, j, false, (it - nP) / HV, (it - nP) % HV); }
    }
}

typedef const __attribute__((address_space(4))) Params* KP;
__device__ __forceinline__ Params ldp(KP kp) {
    asm volatile("" : "+s"(kp));
    Params P;
    P.x_prompt = kp->x_prompt; P.x_sample = kp->x_sample; P.state_pool = kp->state_pool; P.state_conv = kp->state_conv; P.state_delta = kp->state_delta; P.norm_gains = kp->norm_gains;
    P.w_gate = kp->w_gate; P.w_up = kp->w_up; P.w_down = kp->w_down; P.pool_w = kp->pool_w; P.pool_scale = kp->pool_scale; P.dn_w_in = kp->dn_w_in; P.dn_conv_w = kp->dn_conv_w;
    P.dn_a_log = kp->dn_a_log; P.dn_dt_bias = kp->dn_dt_bias; P.dn_norm_w = kp->dn_norm_w; P.dn_w_out = kp->dn_w_out; P.out = kp->out; P.ws = kp->ws;
    return P;
}
__global__ void __launch_bounds__(NTHREADS, 2) mk_fwd(Params Punused) {
    extern __shared__ __attribute__((aligned(16))) unsigned char lds_raw[];
    LAS unsigned char* lds = (LAS unsigned char*)lds_raw;
    cg::grid_group grid = cg::this_grid();
    KP kp = (KP)__builtin_amdgcn_kernarg_segment_ptr();

    { const Params P = ldp(kp); convert_weights((LAS float*)lds, P); }
    { const Params P = ldp(kp); row_pass(P, 0, 0.f, nullptr, P.norm_gains, -1); }
    grid.sync();

#pragma unroll 1
    for (int step = 0; step < 12; ++step) {
        const int layer = step / 3, sub = step % 3, jm = layer >> 1;
        if (sub != 1) {
            const Params P = ldp(kp); const int l = layer * 2 + (sub >> 1);
            pg8::Gemm g{(const bf16_t*)(P.ws + WS_HN), (const bf16_t*)(P.ws + WS_WGU + l * SZ_WGU), D, D, D, 0}; pg8::StaticOrder S; S.init(T, 2 * FF, gridDim.x, blockIdx.x);
            pg8::EpiSwiGLU E{(bf16_t*)(P.ws + WS_H), FF}; pg8::gemm_phase(lds, g, S, E);
        } else if ((layer & 1) == 0) {
            const Params P = ldp(kp); pool_pass(P, jm);
        } else {
            {   const Params P = ldp(kp);
                pg8::Gemm g{(const bf16_t*)(P.ws + WS_HN), (const bf16_t*)(P.ws + WS_WIN + jm * SZ_WIN), D, D, D, 0}; pg8::StaticOrder S; S.init(T, IN_PAD, gridDim.x, blockIdx.x);
                pg8::EpiBf16 E{(bf16_t*)(P.ws + WS_PROJ), IN_PAD}; pg8::gemm_phase(lds, g, S, E); }
            grid.sync();
            { const Params P = ldp(kp); delta_phase(lds, P, jm); }
        }
        grid.sync();
        {   const Params P = ldp(kp);
            pg8::Gemm gf; const float* fscale = nullptr; const bf16_t* A = (const bf16_t*)(P.ws + WS_H);
            if (sub != 1) { const int l = layer * 2 + (sub >> 1); gf = pg8::Gemm{A, (const bf16_t*)(P.ws + WS_WDN + l * SZ_WDN), FF, FF, FF, 0}; }
            else if ((layer & 1) == 0) { gf = pg8::Gemm{A, (const bf16_t*)(P.ws + WS_WPOOL + jm * SZ_WPOOL), 256, D, 256, 256}; fscale = P.pool_scale + jm * D; }
            else gf = pg8::Gemm{A, (const bf16_t*)(P.ws + WS_WOUT + jm * SZ_WOUT), VAL_DIM, VAL_DIM, VAL_DIM, 0};
            pg8::StaticOrder S; S.init(T, D, gridDim.x, blockIdx.x); pg8::EpiF32 E{(float*)(P.ws + WS_Y), D, fscale}; pg8::gemm_phase(lds, gf, S, E); }
        grid.sync();
        {   const Params P = ldp(kp); const float* ng = P.norm_gains + (size_t)layer * 6 * D;
            const float* gpost = ng + (sub == 0 ? 1 : sub == 1 ? 3 : 5) * D;
            const float* gnext = sub == 0 ? ng + 2 * D : sub == 1 ? ng + 4 * D : (layer < 3 ? ng + 6 * D : nullptr);
            row_pass(P, 1, sub == 1 ? 1.0f : 0.5f, gpost, gnext, (sub == 0 && (layer & 1) == 0) ? jm : -1); }
        if (step < 11) grid.sync();
    }
}

extern "C" void kernel_launch(void* const* d_in, const int* in_sizes, int n_in, void* d_out, int out_size, void* d_ws, size_t ws_size, hipStream_t stream) {
    static int grid = 0;
    if (grid == 0) {
        int dev = 0, cus = 0, per_cu = 0;
        if (ws_size < WS_END || n_in != 17) { fprintf(stderr, "kernel_launch: need %zu bytes of workspace (got %zu), 17 inputs (got %d)\n", (size_t)WS_END, ws_size, n_in); grid = -1; return; }
        if (hipGetDevice(&dev) != hipSuccess || hipDeviceGetAttribute(&cus, hipDeviceAttributeMultiprocessorCount, dev) != hipSuccess) { grid = -1; return; }
        if (hipFuncSetAttribute((const void*)mk_fwd, hipFuncAttributeMaxDynamicSharedMemorySize, LDS_BYTES) != hipSuccess) { fprintf(stderr, "hipFuncSetAttribute failed\n"); grid = -1; return; }
        if (hipOccupancyMaxActiveBlocksPerMultiprocessor(&per_cu, (const void*)mk_fwd, NTHREADS, LDS_BYTES) != hipSuccess || per_cu < 1) { fprintf(stderr, "occupancy query: %d\n", per_cu); }
        (void)hipGetLastError();
        grid = cus;
    }
    if (grid < 0) return;
    Params p{};
    p.x_prompt = (const float*)d_in[0]; p.x_sample = (const float*)d_in[1]; p.state_pool = (const float*)d_in[2]; p.state_conv = (const float*)d_in[3]; p.state_delta = (const float*)d_in[4];
    p.norm_gains = (const float*)d_in[5]; p.w_gate = (const float*)d_in[6]; p.w_up = (const float*)d_in[7]; p.w_down = (const float*)d_in[8]; p.pool_w = (const float*)d_in[9];
    p.pool_scale = (const float*)d_in[10]; p.dn_w_in = (const float*)d_in[11]; p.dn_conv_w = (const float*)d_in[12]; p.dn_a_log = (const float*)d_in[13]; p.dn_dt_bias = (const float*)d_in[14];
    p.dn_norm_w = (const float*)d_in[15]; p.dn_w_out = (const float*)d_in[16];
    p.out = (float*)d_out; p.ws = (unsigned char*)d_ws;
    void* args[] = {&p};
    hipError_t e = hipLaunchCooperativeKernel((const void*)mk_fwd, dim3(grid), dim3(NTHREADS), args, LDS_BYTES, stream);
    if (e != hipSuccess) fprintf(stderr, "cooperative launch failed: %s (grid %d)\n", hipGetErrorString(e), grid);
}
```

```cpp
#include <hip/hip_runtime.h>
#include <hip/hip_cooperative_groups.h>
#include <cstdio>
namespace cg = cooperative_groups;

#define LAS __attribute__((address_space(3)))
typedef unsigned short bf16_t;
typedef short bf16x8 __attribute__((ext_vector_type(8)));
typedef float f32x4 __attribute__((ext_vector_type(4)));
typedef float f32x2 __attribute__((ext_vector_type(2)));
typedef unsigned u32x4 __attribute__((ext_vector_type(4)));
typedef unsigned u32x2 __attribute__((ext_vector_type(2)));

constexpr int D = 1024, FF = 2816, SEQ = 2048, NB = 8, DB = 128, DS = 4;
constexpr int TP = NB * SEQ, TS = DB * DS, T = TP + TS;
constexpr int CONV_DIM = 4096, IN_DIM = 6176, IN_PAD = 6400, VAL_DIM = 2048, HV = 16;
constexpr float EPS = 1e-6f;
constexpr int NTHREADS = 512;
constexpr int LDS_BYTES = 132 * 1024;

constexpr size_t SZ_WGU = (size_t)2 * FF * D * 2, SZ_WDN = (size_t)D * FF * 2, SZ_WIN = (size_t)IN_PAD * D * 2, SZ_WOUT = (size_t)D * VAL_DIM * 2, SZ_WPOOL = (size_t)D * 256 * 2;
constexpr size_t WS_WGU = 0;
constexpr size_t WS_WDN = WS_WGU + 8 * SZ_WGU;
constexpr size_t WS_WIN = WS_WDN + 8 * SZ_WDN;
constexpr size_t WS_WOUT = WS_WIN + 2 * SZ_WIN;
constexpr size_t WS_WPOOL = WS_WOUT + 2 * SZ_WOUT;
constexpr size_t WS_HN = WS_WPOOL + 2 * SZ_WPOOL;
constexpr size_t WS_H = WS_HN + (size_t)T * D * 2;
constexpr size_t WS_Y = WS_H + (size_t)T * FF * 2;
constexpr size_t WS_PROJ = WS_Y + (size_t)T * D * 4;
constexpr size_t WS_BAR = WS_PROJ + (size_t)T * IN_PAD * 2;
constexpr size_t WS_END = WS_BAR + 16384;

constexpr size_t O_Y = 0;
constexpr size_t O_POOLP = (size_t)T * D;
constexpr size_t O_CONVP = O_POOLP + (size_t)2 * NB * 15 * D;
constexpr size_t O_DELTAP = O_CONVP + (size_t)2 * NB * 3 * CONV_DIM;
constexpr size_t O_POOLS = O_DELTAP + (size_t)2 * NB * HV * 16384;
constexpr size_t O_CONVS = O_POOLS + (size_t)2 * DB * 15 * D;
constexpr size_t O_DELTAS = O_CONVS + (size_t)2 * DB * 3 * CONV_DIM;

struct Params {
    const float* x_prompt; const float* x_sample; const float* state_pool; const float* state_conv; const float* state_delta; const float* norm_gains;
    const float* w_gate; const float* w_up; const float* w_down; const float* pool_w; const float* pool_scale; const float* dn_w_in; const float* dn_conv_w;
    const float* dn_a_log; const float* dn_dt_bias; const float* dn_norm_w; const float* dn_w_out;
    float* out; unsigned char* ws;
};

__device__ __forceinline__ unsigned cvt_pk_bf16(float lo, float hi) { unsigned r; asm volatile("v_cvt_pk_bf16_f32 %0, %1, %2" : "=v"(r) : "v"(lo), "v"(hi)); return r; }
__device__ __forceinline__ float bf2f(bf16_t b) { return __uint_as_float(((unsigned)b) << 16); }
__device__ __forceinline__ float bflo(unsigned w) { return __uint_as_float(w << 16); }
__device__ __forceinline__ float bfhi(unsigned w) { return __uint_as_float(w & 0xffff0000u); }
__device__ __forceinline__ float silu_f(float x) { return x * __builtin_amdgcn_rcpf(1.0f + __builtin_amdgcn_exp2f(-1.44269504089f * x)); }
__device__ __forceinline__ float wave_sum(float v) {
#pragma unroll
    for (int o = 32; o >= 1; o >>= 1) v += __shfl_xor(v, o);
    return v;
}
__device__ __forceinline__ int opaque_tid() { int t = threadIdx.x; asm volatile("" : "+v"(t)); return t; }
template <int CTRL> __device__ __forceinline__ float dppf(float x) { return __builtin_bit_cast(float, __builtin_amdgcn_mov_dpp(__builtin_bit_cast(int, x), CTRL, 0xf, 0xf, true)); }
__device__ __forceinline__ float red8(float x) { x += dppf<0xB1>(x); x += dppf<0x4E>(x); x += dppf<0x141>(x); return x; }

namespace pg8 {
constexpr int BM = 256, BK = 64, HALF = 128, HTB = HALF * BK * 2, STAGE_BYTES = 8 * HTB, NXCD = 8, WGM = 8;
__device__ __forceinline__ int lds_byte(int r, int c) { const int st = (r >> 4) * 2 + (c >> 5), rr = r & 15, cc = c & 31, ob = rr * 64 + cc * 2; return st * 1024 + (ob ^ (((ob >> 9) & 1) << 5)); }
__device__ __forceinline__ void stage_rc(int b, int& R, int& C) { const int st = b / 1024, sb = b % 1024, swz = sb ^ (((sb >> 9) & 1) << 5); R = (st >> 1) * 16 + swz / 64; C = (st & 1) * 32 + (swz % 64) / 2; }
__device__ __forceinline__ int perm32(int rho) { const int n = rho >> 4, i = rho & 15; return 8 * (i >> 2) + 4 * n + (i & 3); }

struct Unit { int pm, pn; };
struct Gemm { const bf16_t* A; const bf16_t* Bt; int K, lda, ldb, acol; };

struct StaticOrder {
    int nM, nN, nwg, G, c;
    __device__ void init(int M, int N, int G_, int c_) { nM = M / BM; nN = N / BM; nwg = nM * nN; G = G_; c = c_; }
    __device__ bool next(int i, Unit& u) const {
        const long L = (long)i * G + c; if (L >= nwg) return false;
        int wgid = (int)L; { const int q = nwg / NXCD, r = nwg % NXCD, xcd = wgid % NXCD, off = wgid / NXCD; wgid = (xcd < r ? xcd * (q + 1) : r * (q + 1) + (xcd - r) * q) + off; }
        const int nig = WGM * nN, gid = wgid / nig, fm = gid * WGM, gsz = (nM - fm) < WGM ? (nM - fm) : WGM;
        u.pm = fm + ((wgid % nig) % gsz); u.pn = (wgid % nig) / gsz; return true;
    }
};

struct EpiF32 {
    static constexpr bool PERM = false;
    float* C; int ldc; const float* scale;
    __device__ __forceinline__ void operator()(const f32x4 (&acc)[2][2][4][2], const Unit& u, int wr, int wc, int fr, int fq) const {
        const int row0 = u.pm * BM + wr * 64 + fr, col0 = u.pn * BM + wc * 32 + 4 * fq;
        f32x4 sv[2][2];
#pragma unroll
        for (int bj = 0; bj < 2; ++bj)
#pragma unroll
            for (int n = 0; n < 2; ++n) sv[bj][n] = scale ? *(const f32x4*)(scale + col0 + bj * HALF + n * 16) : (f32x4){1.f, 1.f, 1.f, 1.f};
#pragma unroll
        for (int ai = 0; ai < 2; ++ai)
#pragma unroll
            for (int m = 0; m < 4; ++m) { float* rowp = C + (size_t)(row0 + ai * HALF + m * 16) * ldc + col0;
#pragma unroll
                for (int bj = 0; bj < 2; ++bj)
#pragma unroll
                    for (int n = 0; n < 2; ++n) *(f32x4*)(rowp + bj * HALF + n * 16) = acc[ai][bj][m][n] * sv[bj][n]; }
    }
};
struct EpiBf16 {
    static constexpr bool PERM = true;
    bf16_t* O; int ldc;
    __device__ __forceinline__ void operator()(const f32x4 (&acc)[2][2][4][2], const Unit& u, int wr, int wc, int fr, int fq) const {
        const int row0 = u.pm * BM + wr * 64 + fr, col0 = u.pn * BM + wc * 32 + 8 * fq;
#pragma unroll
        for (int ai = 0; ai < 2; ++ai)
#pragma unroll
            for (int m = 0; m < 4; ++m) { bf16_t* rowp = O + (size_t)(row0 + ai * HALF + m * 16) * ldc + col0;
#pragma unroll
                for (int bj = 0; bj < 2; ++bj) { const f32x4 v0 = acc[ai][bj][m][0], v1 = acc[ai][bj][m][1];
                    u32x4 w; w.x = cvt_pk_bf16(v0[0], v0[1]); w.y = cvt_pk_bf16(v0[2], v0[3]); w.z = cvt_pk_bf16(v1[0], v1[1]); w.w = cvt_pk_bf16(v1[2], v1[3]);
                    *(u32x4*)(rowp + bj * HALF) = w; } }
    }
};
struct EpiSwiGLU {
    static constexpr bool PERM = true;
    bf16_t* O; int ldc;
    __device__ __forceinline__ void operator()(const f32x4 (&acc)[2][2][4][2], const Unit& u, int wr, int wc, int fr, int fq) const {
        const int row0 = u.pm * BM + wr * 64 + fr, col0 = u.pn * HALF + wc * 32 + 8 * fq;
#pragma unroll
        for (int ai = 0; ai < 2; ++ai)
#pragma unroll
            for (int m = 0; m < 4; ++m) { bf16_t* rowp = O + (size_t)(row0 + ai * HALF + m * 16) * ldc + col0;
                const f32x4 g0 = acc[ai][0][m][0], g1 = acc[ai][0][m][1], u0 = acc[ai][1][m][0], u1 = acc[ai][1][m][1];
                u32x4 w; w.x = cvt_pk_bf16(silu_f(g0[0]) * u0[0], silu_f(g0[1]) * u0[1]); w.y = cvt_pk_bf16(silu_f(g0[2]) * u0[2], silu_f(g0[3]) * u0[3]);
                w.z = cvt_pk_bf16(silu_f(g1[0]) * u1[0], silu_f(g1[1]) * u1[1]); w.w = cvt_pk_bf16(silu_f(g1[2]) * u1[2], silu_f(g1[3]) * u1[3]);
                *(u32x4*)rowp = w; }
    }
};

template <class Epi, class Sched>
__device__ __forceinline__ void gemm_phase(LAS unsigned char* lds, const Gemm g, const Sched& S, const Epi& E) {
    const int tid = opaque_tid(), wid = __builtin_amdgcn_readfirstlane(tid >> 6), lane = tid & 63, wr = wid >> 2, wc = wid & 3, fr = lane & 15, fq = lane >> 4;
    const int K = g.K, nt = K / BK;
    unsigned voffA[2], voffB[2];
#pragma unroll
    for (int i = 0; i < 2; ++i) { int R, C; stage_rc(tid * 16 + i * 8192, R, C); const int Rb = Epi::PERM ? ((R & ~31) + perm32(R & 31)) : R;
        voffA[i] = (unsigned)(R * g.lda + C) * 2u; voffB[i] = (unsigned)(Rb * g.ldb + C) * 2u; }
    const size_t kstep = (size_t)(BK * 2);
    const size_t hstepA = (size_t)HALF * g.lda * 2, hstepB = (size_t)HALF * g.ldb * 2;
    const size_t tstepA = 2 * hstepA, tstepB = 2 * hstepB;
    const unsigned ldsw = (unsigned)wid * 1024u;
    const int aoff = lds_byte(wr * 64 + fr, fq * 8), boff = lds_byte(wc * 32 + fr, fq * 8);
#define PG8_SA(b, h) (((b) * 2 + (h)) * HTB)
#define PG8_SB(b, h) ((4 + (b) * 2 + (h)) * HTB)
#define PG8_STAGE(bufoff, gbase, voff) do { _Pragma("unroll") for (int _i = 0; _i < 2; ++_i) \
        __builtin_amdgcn_global_load_lds((const unsigned*)((const char*)(gbase) + (voff)[_i]), (LAS unsigned*)(lds + (bufoff) + ldsw + _i * 8192), 16, 0, 0); } while (0)
#define PG8_LDA(dst, b, h) do { _Pragma("unroll") for (int m = 0; m < 4; ++m) _Pragma("unroll") for (int k = 0; k < 2; ++k) dst[m][k] = *(const LAS bf16x8*)(lds + PG8_SA(b, h) + aoff + m * 2048 + k * 1024); } while (0)
#define PG8_LDB(dst, b, h) do { _Pragma("unroll") for (int n = 0; n < 2; ++n) _Pragma("unroll") for (int k = 0; k < 2; ++k) dst[n][k] = *(const LAS bf16x8*)(lds + PG8_SB(b, h) + boff + n * 2048 + k * 1024); } while (0)
#define PG8_MMA(ai, bj, At, Bt) do { __builtin_amdgcn_s_setprio(1); _Pragma("unroll") for (int m = 0; m < 4; ++m) _Pragma("unroll") for (int n = 0; n < 2; ++n) _Pragma("unroll") for (int k = 0; k < 2; ++k) \
        acc[ai][bj][m][n] = __builtin_amdgcn_mfma_f32_16x16x32_bf16(Bt[n][k], At[m][k], acc[ai][bj][m][n], 0, 0, 0); __builtin_amdgcn_s_setprio(0); } while (0)
#define PG8_WAIT_V(n) asm volatile("s_waitcnt vmcnt(" #n ")" ::: "memory")
#define PG8_WAIT_L(n) asm volatile("s_waitcnt lgkmcnt(" #n ")" ::: "memory")
#define PG8_BAR __builtin_amdgcn_s_barrier()
#define PG8_SCHED __builtin_amdgcn_sched_barrier(0)
    Unit cur, nxt; int ui = 0;
    if (!S.next(0, cur)) return;
    f32x4 acc[2][2][4][2];
#pragma unroll
    for (int a = 0; a < 2; ++a)
#pragma unroll
        for (int b = 0; b < 2; ++b)
#pragma unroll
            for (int m = 0; m < 4; ++m)
#pragma unroll
                for (int n = 0; n < 2; ++n) acc[a][b][m][n] = (f32x4){0.f, 0.f, 0.f, 0.f};
    bf16x8 At[4][2], B0[2][2], B1[2][2];
    const char* cA = (const char*)g.A + (size_t)cur.pm * tstepA + (size_t)cur.pn * g.acol * 2; const char* cB = (const char*)g.Bt + (size_t)cur.pn * tstepB;
    PG8_STAGE(PG8_SB(0, 0), cB, voffB); PG8_STAGE(PG8_SA(0, 0), cA, voffA); PG8_STAGE(PG8_SB(0, 1), cB + hstepB, voffB); PG8_STAGE(PG8_SA(0, 1), cA + hstepA, voffA);
    if (wr == 1) PG8_BAR;
    PG8_WAIT_V(4); PG8_BAR;
    PG8_STAGE(PG8_SB(1, 0), cB + kstep, voffB); PG8_STAGE(PG8_SA(1, 0), cA + kstep, voffA); PG8_STAGE(PG8_SB(1, 1), cB + hstepB + kstep, voffB);
    PG8_WAIT_V(6); PG8_BAR;
    for (;;) {
        const bool has_next = S.next(ui + 1, nxt);
        const char* nA = has_next ? (const char*)g.A + (size_t)nxt.pm * tstepA + (size_t)nxt.pn * g.acol * 2 : cA; const char* nB = has_next ? (const char*)g.Bt + (size_t)nxt.pn * tstepB : cB;
        for (int t = 0; t < nt; t += 2) {
            const bool last = (t == nt - 2);
            const char* a1 = cA + (size_t)(t + 1) * kstep;
            const char* a2 = last ? nA : cA + (size_t)(t + 2) * kstep; const char* b2 = last ? nB : cB + (size_t)(t + 2) * kstep;
            const char* a3 = a2 + kstep; const char* b3 = b2 + kstep;
            PG8_LDB(B0, 0, 0); PG8_SCHED; PG8_LDA(At, 0, 0); PG8_STAGE(PG8_SA(1, 1), a1 + hstepA, voffA);
            PG8_WAIT_L(8); PG8_BAR; PG8_WAIT_L(0); PG8_MMA(0, 0, At, B0); PG8_BAR; PG8_SCHED;
            PG8_LDB(B1, 0, 1); PG8_STAGE(PG8_SB(0, 0), b2, voffB);
            PG8_BAR; PG8_WAIT_L(0); PG8_MMA(0, 1, At, B1); PG8_BAR;
            PG8_LDA(At, 0, 1); PG8_STAGE(PG8_SA(0, 0), a2, voffA);
            PG8_BAR; PG8_WAIT_L(0); PG8_MMA(1, 0, At, B0); PG8_BAR; PG8_SCHED;
            PG8_STAGE(PG8_SB(0, 1), b2 + hstepB, voffB);
            PG8_WAIT_V(6); PG8_BAR; PG8_MMA(1, 1, At, B1); PG8_BAR;
            PG8_LDB(B0, 1, 0); PG8_SCHED; PG8_LDA(At, 1, 0); PG8_STAGE(PG8_SA(0, 1), a2 + hstepA, voffA);
            PG8_WAIT_L(8); PG8_BAR; PG8_WAIT_L(0); PG8_MMA(0, 0, At, B0); PG8_BAR; PG8_SCHED;
            PG8_LDB(B1, 1, 1); PG8_STAGE(PG8_SB(1, 0), b3, voffB);
            PG8_BAR; PG8_WAIT_L(0); PG8_MMA(0, 1, At, B1); PG8_BAR;
            PG8_LDA(At, 1, 1); PG8_STAGE(PG8_SA(1, 0), a3, voffA);
            PG8_BAR; PG8_WAIT_L(0); PG8_MMA(1, 0, At, B0); PG8_BAR; PG8_SCHED;
            PG8_STAGE(PG8_SB(1, 1), b3 + hstepB, voffB);
            PG8_WAIT_V(6); PG8_BAR; PG8_MMA(1, 1, At, B1); PG8_BAR;
        }
        E(acc, cur, wr, wc, fr, fq);
        if (!has_next) break;
#pragma unroll
        for (int a = 0; a < 2; ++a)
#pragma unroll
            for (int b = 0; b < 2; ++b)
#pragma unroll
                for (int m = 0; m < 4; ++m)
#pragma unroll
                    for (int n = 0; n < 2; ++n) acc[a][b][m][n] = (f32x4){0.f, 0.f, 0.f, 0.f};
        cur = nxt; cA = nA; cB = nB; ++ui;
    }
    PG8_WAIT_V(0);
    if (wr == 0) PG8_BAR;
    PG8_BAR;
#undef PG8_SA
#undef PG8_SB
#undef PG8_STAGE
#undef PG8_LDA
#undef PG8_LDB
#undef PG8_MMA
#undef PG8_WAIT_V
#undef PG8_WAIT_L
#undef PG8_BAR
#undef PG8_SCHED
}
}

constexpr int CT_GU = 8 * 16 * 88, CT_DN = 8 * 44 * 16, CT_IN = 2 * 16 * 100, CT_OUT = 2 * 32 * 16, CT_POOL = 8 * 4 * 4;
constexpr int CT_TOTAL = CT_GU + CT_DN + CT_IN + CT_OUT + CT_POOL;

__device__ __forceinline__ void convert_weights(LAS float* tile, const Params& P) {
    const int tid = opaque_tid();
    for (int t = blockIdx.x; t < CT_TOTAL; t += gridDim.x) {
        const float* src; int ldsrc, k0, n0, nvalid, lddst, dstrow0; bf16_t* dst;
        if (t < CT_GU) { const int l = t / 1408, rem = t % 1408, kt = rem % 16, rt = rem / 16, r0 = rt * 64, pn = r0 >> 8, bj = (r0 >> 7) & 1, j0 = r0 & 127;
            src = (bj ? P.w_up : P.w_gate) + (size_t)l * D * FF; ldsrc = FF; k0 = kt * 64; n0 = 128 * pn + j0; nvalid = FF; dst = (bf16_t*)(P.ws + WS_WGU + l * SZ_WGU); lddst = D; dstrow0 = r0; }
        else if (t < CT_GU + CT_DN) { const int tt = t - CT_GU, l = tt / 704, rem = tt % 704, kt = rem % 44, nt_ = rem / 44;
            src = P.w_down + (size_t)l * FF * D; ldsrc = D; k0 = kt * 64; n0 = nt_ * 64; nvalid = D; dst = (bf16_t*)(P.ws + WS_WDN + l * SZ_WDN); lddst = FF; dstrow0 = n0; }
        else if (t < CT_GU + CT_DN + CT_IN) { const int tt = t - CT_GU - CT_DN, l = tt / 1600, rem = tt % 1600, kt = rem % 16, nt_ = rem / 16;
            src = P.dn_w_in + (size_t)l * D * IN_DIM; ldsrc = IN_DIM; k0 = kt * 64; n0 = nt_ * 64; nvalid = IN_DIM; dst = (bf16_t*)(P.ws + WS_WIN + l * SZ_WIN); lddst = D; dstrow0 = n0; }
        else if (t < CT_GU + CT_DN + CT_IN + CT_OUT) { const int tt = t - CT_GU - CT_DN - CT_IN, l = tt / 512, rem = tt % 512, kt = rem % 32, nt_ = rem / 32;
            src = P.dn_w_out + (size_t)l * VAL_DIM * D; ldsrc = D; k0 = kt * 64; n0 = nt_ * 64; nvalid = D; dst = (bf16_t*)(P.ws + WS_WOUT + l * SZ_WOUT); lddst = VAL_DIM; dstrow0 = n0; }
        else { const int tt = t - CT_GU - CT_DN - CT_IN - CT_OUT, mtx = tt / 16, rem = tt % 16, kt = rem % 4, nt_ = rem / 4;
            src = P.pool_w + (size_t)mtx * 65536; ldsrc = 256; k0 = kt * 64; n0 = nt_ * 64; nvalid = 256; dst = (bf16_t*)(P.ws + WS_WPOOL) + (size_t)mtx * 65536; lddst = 256; dstrow0 = n0; }
        {   const int rr = tid >> 4, c4 = tid & 15, n = n0 + c4 * 4;
#pragma unroll
            for (int h = 0; h < 2; ++h) { const int k = rr + h * 32;
                f32x4 v = (f32x4){0.f, 0.f, 0.f, 0.f};
                if (n < nvalid) v = *(const f32x4*)(src + (size_t)(k0 + k) * ldsrc + n);
                LAS float* tp = tile + k * 65 + c4 * 4; tp[0] = v[0]; tp[1] = v[1]; tp[2] = v[2]; tp[3] = v[3]; }
        }
        __syncthreads();
        {   const int n = tid >> 3, kg = tid & 7; const LAS float* tp = tile + (kg * 8) * 65 + n;
            u32x4 w; w.x = cvt_pk_bf16(tp[0], tp[65]); w.y = cvt_pk_bf16(tp[130], tp[195]); w.z = cvt_pk_bf16(tp[260], tp[325]); w.w = cvt_pk_bf16(tp[390], tp[455]);
            *(u32x4*)(dst + (size_t)(dstrow0 + n) * lddst + k0 + kg * 8) = w;
        }
        __syncthreads();
    }
}

__device__ __forceinline__ void row_pass(const Params& P, int mode, float coef, const float* gpost, const float* gnext, int pool_j) {
    const int tid = opaque_tid(), lane = tid & 63, wv = tid >> 6;
    float* X = P.out + O_Y; const float* Y = (const float*)(P.ws + WS_Y); bf16_t* HN = (bf16_t*)(P.ws + WS_HN);
    for (int row = blockIdx.x * 8 + wv; row < T; row += gridDim.x * 8) {
        f32x4 x[4];
        if (mode == 0) { const float* src = row < TP ? P.x_prompt + (size_t)row * D : P.x_sample + (size_t)(row - TP) * D;
#pragma unroll
            for (int i = 0; i < 4; ++i) x[i] = *(const f32x4*)(src + i * 256 + lane * 4); }
        else { f32x4 y[4]; float ss = 0.f;
#pragma unroll
            for (int i = 0; i < 4; ++i) { y[i] = *(const f32x4*)(Y + (size_t)row * D + i * 256 + lane * 4); x[i] = *(const f32x4*)(X + (size_t)row * D + i * 256 + lane * 4);
                ss += y[i][0] * y[i][0] + y[i][1] * y[i][1] + y[i][2] * y[i][2] + y[i][3] * y[i][3]; }
            ss = wave_sum(ss); const float r = coef * __builtin_amdgcn_rsqf(ss * (1.0f / D) + EPS);
#pragma unroll
            for (int i = 0; i < 4; ++i) { const f32x4 gp = *(const f32x4*)(gpost + i * 256 + lane * 4); x[i] += y[i] * gp * r; } }
#pragma unroll
        for (int i = 0; i < 4; ++i) *(f32x4*)(X + (size_t)row * D + i * 256 + lane * 4) = x[i];
        if (gnext) { float ss = 0.f;
#pragma unroll
            for (int i = 0; i < 4; ++i) ss += x[i][0] * x[i][0] + x[i][1] * x[i][1] + x[i][2] * x[i][2] + x[i][3] * x[i][3];
            ss = wave_sum(ss); const float r = __builtin_amdgcn_rsqf(ss * (1.0f / D) + EPS);
            float* pdst = nullptr;
            if (pool_j >= 0) { if (row < TP) { const int b = row / SEQ, s = row % SEQ; if (s >= SEQ - 15) pdst = P.out + O_POOLP + ((size_t)(pool_j * NB + b) * 15 + (s - (SEQ - 15))) * D; }
                               else { const int b = (row - TP) / DS, s = (row - TP) % DS; pdst = P.out + O_POOLS + ((size_t)(pool_j * DB + b) * 15 + 11 + s) * D; } }
#pragma unroll
            for (int i = 0; i < 4; ++i) { const f32x4 gn = *(const f32x4*)(gnext + i * 256 + lane * 4); const f32x4 h = x[i] * gn * r;
                u32x2 w; w.x = cvt_pk_bf16(h[0], h[1]); w.y = cvt_pk_bf16(h[2], h[3]); *(u32x2*)(HN + (size_t)row * D + i * 256 + lane * 4) = w;
                if (pdst) *(f32x4*)(pdst + i * 256 + lane * 4) = h; } }
    }
}

__device__ __forceinline__ void pool_pass(const Params& P, int j) {
    const bf16_t* HN = (const bf16_t*)(P.ws + WS_HN); bf16_t* PO = (bf16_t*)(P.ws + WS_H);
    const float* past = P.state_pool + (size_t)j * DB * 15 * D;
    const size_t gtid = (size_t)blockIdx.x * NTHREADS + opaque_tid(), gsz = (size_t)gridDim.x * NTHREADS;
    for (size_t it = gtid; it < (size_t)T * 128; it += gsz) {
        const int row = (int)(it >> 7), ch = (int)(it & 127), col = ch * 8, w = 2 << (ch >> 5);
        float a[8];
#pragma unroll
        for (int q = 0; q < 8; ++q) a[q] = 0.f;
        const u32x4 self = *(const u32x4*)(HN + (size_t)row * D + col);
        float cnt;
        if (row < TP) { const int s = row % SEQ; const int n = (s + 1 < w) ? s + 1 : w; cnt = (float)n;
            for (int i = 0; i < n; ++i) { const u32x4 v = *(const u32x4*)(HN + (size_t)(row - i) * D + col);
                a[0] += bflo(v.x); a[1] += bfhi(v.x); a[2] += bflo(v.y); a[3] += bfhi(v.y); a[4] += bflo(v.z); a[5] += bfhi(v.z); a[6] += bflo(v.w); a[7] += bfhi(v.w); } }
        else { const int b = (row - TP) / DS, s = (row - TP) % DS; cnt = (float)w;
            for (int i = 0; i < w; ++i) {
                if (s - i >= 0) { const u32x4 v = *(const u32x4*)(HN + (size_t)(row - i) * D + col);
                    a[0] += bflo(v.x); a[1] += bfhi(v.x); a[2] += bflo(v.y); a[3] += bfhi(v.y); a[4] += bflo(v.z); a[5] += bfhi(v.z); a[6] += bflo(v.w); a[7] += bfhi(v.w); }
                else { const float* pp = past + ((size_t)b * 15 + (15 + s - i)) * D + col; const f32x4 v0 = *(const f32x4*)pp, v1 = *(const f32x4*)(pp + 4);
                    a[0] += v0[0]; a[1] += v0[1]; a[2] += v0[2]; a[3] += v0[3]; a[4] += v1[0]; a[5] += v1[1]; a[6] += v1[2]; a[7] += v1[3]; } } }
        const float ic = 1.0f / cnt;
        u32x4 o; o.x = cvt_pk_bf16(a[0] * ic - bflo(self.x), a[1] * ic - bfhi(self.x)); o.y = cvt_pk_bf16(a[2] * ic - bflo(self.y), a[3] * ic - bfhi(self.y));
        o.z = cvt_pk_bf16(a[4] * ic - bflo(self.z), a[5] * ic - bfhi(self.z)); o.w = cvt_pk_bf16(a[6] * ic - bflo(self.w), a[7] * ic - bfhi(self.w));
        *(u32x4*)(PO + (size_t)row * D + col) = o;
    }
    float* dst = P.out + O_POOLS + (size_t)j * DB * 15 * D;
    for (size_t it = gtid; it < (size_t)DB * 11 * (D / 4); it += gsz) { const int b = (int)(it / (11 * 256)), r = (int)(it % (11 * 256)), p = r / 256, c4 = r % 256;
        *(f32x4*)(dst + ((size_t)b * 15 + p) * D + c4 * 4) = *(const f32x4*)(past + ((size_t)b * 15 + p + 4) * D + c4 * 4); }
}

constexpr int TB = 32;
constexpr int L_QS = 0, L_KS = 16384, L_VS = 32768, L_OS = 49152, L_GBK = 65536, L_CW = 66048, L_RAW = 72192, L_Z = 99072, L_BA = 107264;
constexpr int RAW_PIECES = (TB + 3) * 48;
__device__ __forceinline__ int seg_col(int seg, int hk, int hv) { return seg == 0 ? hk * 128 : (seg == 1 ? 1024 + hk * 128 : 2048 + hv * 128); }
__device__ __forceinline__ void delta_fetch(const bf16_t* proj, const float* cpast, bool isPrompt, int row0, int ntok, int t0, int hk, int hv, int tid, u32x4 (&rr)[4], u32x4& rz, unsigned& rba) {
#pragma unroll
    for (int i = 0; i < 4; ++i) { const int p = tid + NTHREADS * i; rr[i] = (u32x4){0u, 0u, 0u, 0u};
        if (p < RAW_PIECES) { const int r = p / 48, q48 = p % 48, seg = q48 >> 4, l16 = q48 & 15, tt = t0 - 3 + r, col = seg_col(seg, hk, hv) + l16 * 8;
            if (tt >= 0) { if (tt < ntok) rr[i] = *(const u32x4*)(proj + (size_t)(row0 + tt) * IN_PAD + col); }
            else if (!isPrompt) { const float* f = cpast + (3 + tt) * CONV_DIM + col; const f32x4 a = *(const f32x4*)f, c = *(const f32x4*)(f + 4);
                rr[i] = (u32x4){cvt_pk_bf16(a[0], a[1]), cvt_pk_bf16(a[2], a[3]), cvt_pk_bf16(c[0], c[1]), cvt_pk_bf16(c[2], c[3])}; } } }
    {   const int r = tid >> 4, l16 = tid & 15, tt = t0 + r; rz = (u32x4){0u, 0u, 0u, 0u};
        if (tt < ntok) rz = *(const u32x4*)(proj + (size_t)(row0 + tt) * IN_PAD + 4096 + hv * 128 + l16 * 8); }
    rba = 0u;
    if (tid < 2 * TB) { const int r = tid >> 1, tt = t0 + r; if (tt < ntok) rba = proj[(size_t)(row0 + tt) * IN_PAD + 6144 + (tid & 1) * 16 + hv]; }
}
__device__ __forceinline__ void delta_item(LAS unsigned char* LB, const Params& P, int j, bool isPrompt, int b, int hv) {
    const int tid = opaque_tid(), lane = tid & 63, wv = tid >> 6, dg = lane & 7, ep = lane >> 3, ecol = 16 * wv + 2 * ep, hk = hv >> 1;
    LAS float* L = (LAS float*)LB; LAS float* qs = (LAS float*)(LB + L_QS); LAS float* ks = (LAS float*)(LB + L_KS); LAS float* vs = (LAS float*)(LB + L_VS); LAS float* os = (LAS float*)(LB + L_OS);
    LAS float* gbk = (LAS float*)(LB + L_GBK); LAS float* cw = (LAS float*)(LB + L_CW); LAS bf16_t* raw = (LAS bf16_t*)(LB + L_RAW); LAS bf16_t* zr = (LAS bf16_t*)(LB + L_Z); LAS bf16_t* ba = (LAS bf16_t*)(LB + L_BA);
    const bf16_t* proj = (const bf16_t*)(P.ws + WS_PROJ); bf16_t* OG = (bf16_t*)(P.ws + WS_H);
    const float* conv_w = P.dn_conv_w + (size_t)j * 4 * CONV_DIM; const float* normw = P.dn_norm_w + j * 128;
    const float alog = P.dn_a_log[j * HV + hv], dtb = P.dn_dt_bias[j * HV + hv];
    const int row0 = isPrompt ? b * SEQ : TP + b * DS, ntok = isPrompt ? SEQ : DS;
    const float* cpast = P.state_conv + (size_t)(j * DB + b) * 3 * CONV_DIM;
    u32x4 rr[4], rz; unsigned rba;
    delta_fetch(proj, cpast, isPrompt, row0, ntok, 0, hk, hv, tid, rr, rz, rba);
    for (int idx = tid; idx < 4 * 384; idx += NTHREADS) { const int jj = idx / 384, ch = idx % 384; cw[idx] = conv_w[jj * CONV_DIM + seg_col(ch >> 7, hk, hv) + (ch & 127)]; }
    f32x2 s[16];
    if (isPrompt) {
#pragma unroll
        for (int i = 0; i < 16; ++i) s[i] = (f32x2){0.f, 0.f}; }
    else { const float* s0 = P.state_delta + ((size_t)(j * DB + b) * HV + hv) * 16384;
#pragma unroll
        for (int i = 0; i < 16; ++i) s[i] = *(const f32x2*)(s0 + (32 * (i >> 2) + 4 * dg + (i & 3)) * 128 + ecol); }
    const f32x2 nw = *(const f32x2*)(normw + lane * 2);
    const float nalog = -__expf(alog);
    float Gacc = 0.f;
    for (int t0 = 0; t0 < ntok; t0 += TB) {
        const int nb = (ntok - t0) < TB ? (ntok - t0) : TB;
#pragma unroll
        for (int i = 0; i < 4; ++i) { const int p = tid + NTHREADS * i; if (p < RAW_PIECES) *(LAS u32x4*)(raw + p * 8) = rr[i]; }
        *(LAS u32x4*)(zr + tid * 8) = rz;
        if (tid < 2 * TB) ba[tid] = (bf16_t)rba;
        __syncthreads();
        if (t0 + TB < ntok) delta_fetch(proj, cpast, isPrompt, row0, ntok, t0 + TB, hk, hv, tid, rr, rz, rba);
        for (int idx = tid; idx < nb * 384; idx += NTHREADS) {
            const int tok = idx / 384, ch = idx % 384;
            float acc = 0.f;
#pragma unroll
            for (int jj = 0; jj < 4; ++jj) acc += bf2f(raw[(tok + jj) * 384 + ch]) * cw[jj * 384 + ch];
            L[(ch >> 7) * TB * 128 + tok * 128 + (ch & 127)] = silu_f(acc);
        }
        if (tid < nb) { const float bb = bf2f(ba[tid * 2]), aa = bf2f(ba[tid * 2 + 1]) + dtb;
            const float sp = aa > 20.f ? aa : log1pf(__expf(aa)); gbk[tid * 4] = nalog * sp; gbk[tid * 4 + 1] = 1.0f / (1.0f + __expf(-bb)); }
        __syncthreads();
        for (int tok = wv; tok < nb; tok += 8) { f32x2 q = *(LAS f32x2*)(qs + tok * 128 + lane * 2), k = *(LAS f32x2*)(ks + tok * 128 + lane * 2);
            const float sq = wave_sum(q.x * q.x + q.y * q.y), sk = wave_sum(k.x * k.x + k.y * k.y);
            const float rq = __builtin_amdgcn_rsqf(sq + EPS) * 0.08838834764831845f, rk = __builtin_amdgcn_rsqf(sk + EPS);
            q *= rq; k *= rk; *(LAS f32x2*)(qs + tok * 128 + lane * 2) = q; *(LAS f32x2*)(ks + tok * 128 + lane * 2) = k;
            const float kq = wave_sum(q.x * k.x + q.y * k.y); if (lane == 0) gbk[tok * 4 + 2] = kq; }
        __syncthreads();
        for (int tok = 0; tok < nb; ++tok) {
            f32x4 kv[4], qv[4];
#pragma unroll
            for (int i = 0; i < 4; ++i) { kv[i] = *(const LAS f32x4*)(ks + tok * 128 + 32 * i + 4 * dg); qv[i] = *(const LAS f32x4*)(qs + tok * 128 + 32 * i + 4 * dg); }
            const f32x2 v = *(const LAS f32x2*)(vs + tok * 128 + ecol);
            const f32x4 gb = *(const LAS f32x4*)(gbk + tok * 4);
            const float g = gb[0], beta = gb[1], kq = gb[2];
            float Gn = Gacc + g;
            if (Gn < -30.f) { const float f = __expf(Gn);
#pragma unroll
                for (int i = 0; i < 16; ++i) s[i] *= f;
                Gn = 0.f; }
            Gacc = Gn;
            f32x2 pp0 = (f32x2){0.f, 0.f}, pp1 = pp0, oo0 = pp0, oo1 = pp0;
#pragma unroll
            for (int i = 0; i < 16; i += 2) { pp0 += s[i] * kv[i >> 2][i & 3]; oo0 += s[i] * qv[i >> 2][i & 3]; pp1 += s[i + 1] * kv[i >> 2][(i & 3) + 1]; oo1 += s[i + 1] * qv[i >> 2][(i & 3) + 1]; }
            f32x2 pp = pp0 + pp1, oo = oo0 + oo1;
            pp.x = red8(pp.x); pp.y = red8(pp.y); oo.x = red8(oo.x); oo.y = red8(oo.y);
            const float c = __expf(Gacc), ic = __expf(-Gacc);
            const f32x2 dl = (v - pp * c) * beta, dt = dl * ic;
#pragma unroll
            for (int i = 0; i < 16; ++i) s[i] += dt * kv[i >> 2][i & 3];
            const f32x2 o = oo * c + dl * kq;
            if (dg == 0) *(LAS f32x2*)(os + tok * 128 + ecol) = o;
        }
        __syncthreads();
        for (int tok = wv; tok < nb; tok += 8) { const f32x2 o = *(const LAS f32x2*)(os + tok * 128 + lane * 2);
            const float ss = wave_sum(o.x * o.x + o.y * o.y), r = __builtin_amdgcn_rsqf(ss * (1.0f / 128.f) + EPS);
            const unsigned zz = *(const LAS unsigned*)(zr + tok * 128 + lane * 2);
            *(unsigned*)(OG + (size_t)(row0 + t0 + tok) * VAL_DIM + hv * 128 + lane * 2) = cvt_pk_bf16(o.x * r * nw.x * silu_f(bflo(zz)), o.y * r * nw.y * silu_f(bfhi(zz))); }
        __syncthreads();
    }
    {   const float c = __expf(Gacc);
        float* sd = isPrompt ? P.out + O_DELTAP + ((size_t)(j * NB + b) * HV + hv) * 16384 : P.out + O_DELTAS + ((size_t)(j * DB + b) * HV + hv) * 16384;
#pragma unroll
        for (int i = 0; i < 16; ++i) *(f32x2*)(sd + (32 * (i >> 2) + 4 * dg + (i & 3)) * 128 + ecol) = s[i] * c; }
}
__device__ __forceinline__ void delta_phase(LAS unsigned char* L, const Params& P, int j) {
    const int G = gridDim.x, bid = blockIdx.x;
    const bf16_t* proj = (const bf16_t*)(P.ws + WS_PROJ);
    {
        const size_t gtid = (size_t)bid * NTHREADS + opaque_tid(), gsz = (size_t)G * NTHREADS;
        for (size_t it = gtid; it < (size_t)NB * 3 * CONV_DIM; it += gsz) { const int b = (int)(it / (3 * CONV_DIM)), r = (int)(it % (3 * CONV_DIM)), p = r / CONV_DIM, c = r % CONV_DIM;
            P.out[O_CONVP + (size_t)j * NB * 3 * CONV_DIM + it] = bf2f(proj[(size_t)(b * SEQ + SEQ - 3 + p) * IN_PAD + c]); }
        for (size_t it = gtid; it < (size_t)DB * 3 * CONV_DIM; it += gsz) { const int b = (int)(it / (3 * CONV_DIM)), r = (int)(it % (3 * CONV_DIM)), p = r / CONV_DIM, c = r % CONV_DIM;
            P.out[O_CONVS + (size_t)j * DB * 3 * CONV_DIM + it] = bf2f(proj[(size_t)(TP + b * DS + 1 + p) * IN_PAD + c]); }
    }
    const int nP = NB * HV, nS = DB * HV;
    if (G >= 2 * nP) {
        if (bid < nP) delta_item(L, P, j, true, bid / HV, bid % HV);
        else for (int it = bid - nP; it < nS; it += G - nP) delta_item(L, P, j, false, it / HV, it % HV);
    } else {
        for (int it = bid; it < nP + nS; it += G) { if (it < nP) delta_item(L, P, j, true, it / HV, it % HV); else delta_item(L, P, j, false, (it - nP) / HV, (it - nP) % HV); }
    }
}

#define XB_TMO      128
#define XB_XCNT(j)  (256  + 64 * (j))
#define XB_XSUB(j)  (1280 + 64 * (j))
#define XB_XGEN(j)  (2304 + 64 * (j))
#define XB_TOP      3328
#define XB_TOPGEN   3392
#define XCD_BAR_WORDS 3456
#define XB_SPIN_CAP (1u << 22)
constexpr int LDS_ST_OFF = 131072 + 1024;
__device__ __forceinline__ unsigned xb_ld(unsigned* p)              { return __hip_atomic_load(p, __ATOMIC_RELAXED, __HIP_MEMORY_SCOPE_AGENT); }
__device__ __forceinline__ unsigned xb_add(unsigned* p, unsigned v) { return __hip_atomic_fetch_add(p, v, __ATOMIC_RELAXED, __HIP_MEMORY_SCOPE_AGENT); }
__device__ __forceinline__ unsigned xb_xcc_id() { return (unsigned)__builtin_amdgcn_s_getreg((3 << 11) | 20) & 0xFu; }
#define XB_SPIN(cond, bar) do { unsigned _sp = 0; while (cond) { __builtin_amdgcn_s_sleep(1); \
    if ((++_sp & 255u) == 0u) { if (xb_ld(&(bar)[XB_TMO])) break; if (_sp > XB_SPIN_CAP) { atomicAdd(&(bar)[XB_TMO], 1u); break; } } } } while (0)
__device__ __forceinline__ void xcd_barrier_complete(unsigned* bar, unsigned x, unsigned& nloc, unsigned& nx) {
    const unsigned G = gridDim.x;
    unsigned sum, cnt, mine, sp = 0u;
    for (;;) {
        sum = 0u; cnt = 0u; mine = 0u;
#pragma unroll
        for (unsigned j = 0; j < 16; ++j) { const unsigned c = xb_ld(&bar[XB_XCNT(j)]); sum += c; cnt += (c > 0u) ? 1u : 0u; mine = (j == x) ? c : mine; }
        if (sum == G) break;
        __builtin_amdgcn_s_sleep(1);
        if ((++sp & 255u) == 0u) { if (xb_ld(&bar[XB_TMO])) break; if (sp > XB_SPIN_CAP) { atomicAdd(&bar[XB_TMO], 1u); break; } }
    }
    nloc = mine > 0u ? mine : 1u; nx = cnt > 0u ? cnt : 1u;
}
__device__ __forceinline__ void xcd_barrier(unsigned* bar, volatile LAS unsigned* st) {
    asm volatile("s_waitcnt vmcnt(0)" ::: "memory");
    __syncthreads();
    if (threadIdx.x == 0) {
        const unsigned x = xb_xcc_id();
        __builtin_amdgcn_s_waitcnt(0);
        unsigned nloc = st[0], nx = st[1];
        if (nloc == 0u) { xcd_barrier_complete(bar, x, nloc, nx); st[0] = nloc; st[1] = nx; }
        const unsigned old = xb_add(&bar[XB_XSUB(x)], 1u);
        const unsigned gen = old / nloc;
        if (old + 1u == (gen + 1u) * nloc) {
            __builtin_amdgcn_fence(__ATOMIC_RELEASE, "agent");
            asm volatile("s_waitcnt vmcnt(0)" ::: "memory");
            const unsigned og = xb_add(&bar[XB_TOP], 1u);
            const unsigned tg = og / nx;
            if (og + 1u == (tg + 1u) * nx) xb_add(&bar[XB_TOPGEN], 1u);
            else XB_SPIN(xb_ld(&bar[XB_TOPGEN]) == tg, bar);
            __builtin_amdgcn_fence(__ATOMIC_ACQUIRE, "agent");
            xb_add(&bar[XB_XGEN(x)], 1u);
            asm volatile("s_waitcnt vmcnt(0)" ::: "memory");
        } else {
            XB_SPIN(xb_ld(&bar[XB_XGEN(x)]) == gen, bar);
            __builtin_amdgcn_fence(__ATOMIC_ACQUIRE, "agent");
            asm volatile("s_waitcnt vmcnt(0)" ::: "memory");
        }
    }
    __syncthreads();
}

typedef const __attribute__((address_space(4))) Params* KP;
__device__ __forceinline__ Params ldp(KP kp) {
    asm volatile("" : "+s"(kp));
    Params P;
    P.x_prompt = kp->x_prompt; P.x_sample = kp->x_sample; P.state_pool = kp->state_pool; P.state_conv = kp->state_conv; P.state_delta = kp->state_delta; P.norm_gains = kp->norm_gains;
    P.w_gate = kp->w_gate; P.w_up = kp->w_up; P.w_down = kp->w_down; P.pool_w = kp->pool_w; P.pool_scale = kp->pool_scale; P.dn_w_in = kp->dn_w_in; P.dn_conv_w = kp->dn_conv_w;
    P.dn_a_log = kp->dn_a_log; P.dn_dt_bias = kp->dn_dt_bias; P.dn_norm_w = kp->dn_norm_w; P.dn_w_out = kp->dn_w_out; P.out = kp->out; P.ws = kp->ws;
    return P;
}
__global__ void __launch_bounds__(NTHREADS, 2) mk_fwd(Params Punused) {
    extern __shared__ __attribute__((aligned(16))) unsigned char lds_raw[];
    LAS unsigned char* lds = (LAS unsigned char*)lds_raw;
    cg::grid_group grid = cg::this_grid();
    KP kp = (KP)__builtin_amdgcn_kernarg_segment_ptr();

    {   const Params P = ldp(kp); unsigned* bar = (unsigned*)(P.ws + WS_BAR);
        if (blockIdx.x == 0) for (int i = threadIdx.x; i < XCD_BAR_WORDS; i += NTHREADS) bar[i] = 0u;
        if (threadIdx.x == 0) { ((volatile LAS unsigned*)(lds + LDS_ST_OFF))[0] = 0u; ((volatile LAS unsigned*)(lds + LDS_ST_OFF))[1] = 0u; } }
    { const Params P = ldp(kp); convert_weights((LAS float*)lds, P); }
    { const Params P = ldp(kp); row_pass(P, 0, 0.f, nullptr, P.norm_gains, -1); }
    grid.sync();
    if (threadIdx.x == 0) { const Params P = ldp(kp); (void)xb_add(&((unsigned*)(P.ws + WS_BAR))[XB_XCNT(xb_xcc_id())], 1u); }
#define GBAR() do { const Params Pb = ldp(kp); xcd_barrier((unsigned*)(Pb.ws + WS_BAR), (volatile LAS unsigned*)(lds + LDS_ST_OFF)); } while (0)

#pragma unroll 1
    for (int step = 0; step < 12; ++step) {
        const int layer = step / 3, sub = step % 3, jm = layer >> 1;
        if (sub != 1) {
            const Params P = ldp(kp); const int l = layer * 2 + (sub >> 1);
            pg8::Gemm g{(const bf16_t*)(P.ws + WS_HN), (const bf16_t*)(P.ws + WS_WGU + l * SZ_WGU), D, D, D, 0}; pg8::StaticOrder S; S.init(T, 2 * FF, gridDim.x, blockIdx.x);
            pg8::EpiSwiGLU E{(bf16_t*)(P.ws + WS_H), FF}; pg8::gemm_phase(lds, g, S, E);
        } else if ((layer & 1) == 0) {
            const Params P = ldp(kp); pool_pass(P, jm);
        } else {
            {   const Params P = ldp(kp);
                pg8::Gemm g{(const bf16_t*)(P.ws + WS_HN), (const bf16_t*)(P.ws + WS_WIN + jm * SZ_WIN), D, D, D, 0}; pg8::StaticOrder S; S.init(T, IN_PAD, gridDim.x, blockIdx.x);
                pg8::EpiBf16 E{(bf16_t*)(P.ws + WS_PROJ), IN_PAD}; pg8::gemm_phase(lds, g, S, E); }
            GBAR();
            { const Params P = ldp(kp); delta_phase(lds, P, jm); }
        }
        GBAR();
        {   const Params P = ldp(kp);
            pg8::Gemm gf; const float* fscale = nullptr; const bf16_t* A = (const bf16_t*)(P.ws + WS_H);
            if (sub != 1) { const int l = layer * 2 + (sub >> 1); gf = pg8::Gemm{A, (const bf16_t*)(P.ws + WS_WDN + l * SZ_WDN), FF, FF, FF, 0}; }
            else if ((layer & 1) == 0) { gf = pg8::Gemm{A, (const bf16_t*)(P.ws + WS_WPOOL + jm * SZ_WPOOL), 256, D, 256, 256}; fscale = P.pool_scale + jm * D; }
            else gf = pg8::Gemm{A, (const bf16_t*)(P.ws + WS_WOUT + jm * SZ_WOUT), VAL_DIM, VAL_DIM, VAL_DIM, 0};
            pg8::StaticOrder S; S.init(T, D, gridDim.x, blockIdx.x); pg8::EpiF32 E{(float*)(P.ws + WS_Y), D, fscale}; pg8::gemm_phase(lds, gf, S, E); }
        GBAR();
        {   const Params P = ldp(kp); const float* ng = P.norm_gains + (size_t)layer * 6 * D;
            const float* gpost = ng + (sub == 0 ? 1 : sub == 1 ? 3 : 5) * D;
            const float* gnext = sub == 0 ? ng + 2 * D : sub == 1 ? ng + 4 * D : (layer < 3 ? ng + 6 * D : nullptr);
            row_pass(P, 1, sub == 1 ? 1.0f : 0.5f, gpost, gnext, (sub == 0 && (layer & 1) == 0) ? jm : -1); }
        if (step < 11) GBAR();
    }
}

extern "C" void kernel_launch(void* const* d_in, const int* in_sizes, int n_in, void* d_out, int out_size, void* d_ws, size_t ws_size, hipStream_t stream) {
    static int grid = 0;
    if (grid == 0) {
        int dev = 0, cus = 0, per_cu = 0;
        if (ws_size < WS_END || n_in != 17) { fprintf(stderr, "kernel_launch: need %zu bytes of workspace (got %zu), 17 inputs (got %d)\n", (size_t)WS_END, ws_size, n_in); grid = -1; return; }
        if (hipGetDevice(&dev) != hipSuccess || hipDeviceGetAttribute(&cus, hipDeviceAttributeMultiprocessorCount, dev) != hipSuccess) { grid = -1; return; }
        if (hipFuncSetAttribute((const void*)mk_fwd, hipFuncAttributeMaxDynamicSharedMemorySize, LDS_BYTES) != hipSuccess) { fprintf(stderr, "hipFuncSetAttribute failed\n"); grid = -1; return; }
        if (hipOccupancyMaxActiveBlocksPerMultiprocessor(&per_cu, (const void*)mk_fwd, NTHREADS, LDS_BYTES) != hipSuccess || per_cu < 1) { fprintf(stderr, "occupancy query: %d\n", per_cu); }
        (void)hipGetLastError();
        grid = cus;
    }
    if (grid < 0) return;
    Params p{};
    p.x_prompt = (const float*)d_in[0]; p.x_sample = (const float*)d_in[1]; p.state_pool = (const float*)d_in[2]; p.state_conv = (const float*)d_in[3]; p.state_delta = (const float*)d_in[4];
    p.norm_gains = (const float*)d_in[5]; p.w_gate = (const float*)d_in[6]; p.w_up = (const float*)d_in[7]; p.w_down = (const float*)d_in[8]; p.pool_w = (const float*)d_in[9];
    p.pool_scale = (const float*)d_in[10]; p.dn_w_in = (const float*)d_in[11]; p.dn_conv_w = (const float*)d_in[12]; p.dn_a_log = (const float*)d_in[13]; p.dn_dt_bias = (const float*)d_in[14];
    p.dn_norm_w = (const float*)d_in[15]; p.dn_w_out = (const float*)d_in[16];
    p.out = (float*)d_out; p.ws = (unsigned char*)d_ws;
    void* args[] = {&p};
    hipError_t e = hipLaunchCooperativeKernel((const void*)mk_fwd, dim3(grid), dim3(NTHREADS), args, LDS_BYTES, stream);
    if (e != hipSuccess) fprintf(stderr, "cooperative launch failed: %s (grid %d)\n", hipGetErrorString(e), grid);
}
```

```cpp
#include <hip/hip_runtime.h>
#include <hip/hip_cooperative_groups.h>
#include <cstdio>
namespace cg = cooperative_groups;

#define LAS __attribute__((address_space(3)))
typedef unsigned short bf16_t;
typedef short bf16x8 __attribute__((ext_vector_type(8)));
typedef float f32x4 __attribute__((ext_vector_type(4)));
typedef float f32x2 __attribute__((ext_vector_type(2)));
typedef unsigned u32x4 __attribute__((ext_vector_type(4)));
typedef unsigned u32x2 __attribute__((ext_vector_type(2)));

constexpr int D = 1024, FF = 2816, SEQ = 2048, NB = 8, DB = 128, DS = 4;
constexpr int TP = NB * SEQ, TS = DB * DS, T = TP + TS;
constexpr int CONV_DIM = 4096, IN_DIM = 6176, IN_PAD = 6400, VAL_DIM = 2048, HV = 16;
constexpr float EPS = 1e-6f;
constexpr int NTHREADS = 512;
constexpr int LDS_BYTES = 144 * 1024;

constexpr size_t SZ_WGU = (size_t)2 * FF * D * 2, SZ_WDN = (size_t)D * FF * 2, SZ_WIN = (size_t)IN_PAD * D * 2, SZ_WOUT = (size_t)D * VAL_DIM * 2, SZ_WPOOL = (size_t)D * 256 * 2;
constexpr size_t WS_WGU = 0;
constexpr size_t WS_WDN = WS_WGU + 8 * SZ_WGU;
constexpr size_t WS_WIN = WS_WDN + 8 * SZ_WDN;
constexpr size_t WS_WOUT = WS_WIN + 2 * SZ_WIN;
constexpr size_t WS_WPOOL = WS_WOUT + 2 * SZ_WOUT;
constexpr size_t WS_HN = WS_WPOOL + 2 * SZ_WPOOL;
constexpr size_t WS_H = WS_HN + (size_t)T * D * 2;
constexpr size_t WS_Y = WS_H + (size_t)T * FF * 2;
constexpr size_t WS_PROJ = WS_Y + (size_t)T * D * 4;
constexpr size_t WS_BAR = WS_PROJ + (size_t)T * IN_PAD * 2;
constexpr size_t WS_END = WS_BAR + 16384;

constexpr size_t O_Y = 0;
constexpr size_t O_POOLP = (size_t)T * D;
constexpr size_t O_CONVP = O_POOLP + (size_t)2 * NB * 15 * D;
constexpr size_t O_DELTAP = O_CONVP + (size_t)2 * NB * 3 * CONV_DIM;
constexpr size_t O_POOLS = O_DELTAP + (size_t)2 * NB * HV * 16384;
constexpr size_t O_CONVS = O_POOLS + (size_t)2 * DB * 15 * D;
constexpr size_t O_DELTAS = O_CONVS + (size_t)2 * DB * 3 * CONV_DIM;

struct Params {
    const float* x_prompt; const float* x_sample; const float* state_pool; const float* state_conv; const float* state_delta; const float* norm_gains;
    const float* w_gate; const float* w_up; const float* w_down; const float* pool_w; const float* pool_scale; const float* dn_w_in; const float* dn_conv_w;
    const float* dn_a_log; const float* dn_dt_bias; const float* dn_norm_w; const float* dn_w_out;
    float* out; unsigned char* ws;
};

__device__ __forceinline__ unsigned cvt_pk_bf16(float lo, float hi) { unsigned r; asm volatile("v_cvt_pk_bf16_f32 %0, %1, %2" : "=v"(r) : "v"(lo), "v"(hi)); return r; }
__device__ __forceinline__ float bf2f(bf16_t b) { return __uint_as_float(((unsigned)b) << 16); }
__device__ __forceinline__ float bflo(unsigned w) { return __uint_as_float(w << 16); }
__device__ __forceinline__ float bfhi(unsigned w) { return __uint_as_float(w & 0xffff0000u); }
__device__ __forceinline__ float silu_f(float x) { return x * __builtin_amdgcn_rcpf(1.0f + __builtin_amdgcn_exp2f(-1.44269504089f * x)); }
__device__ __forceinline__ float wave_sum(float v) {
#pragma unroll
    for (int o = 32; o >= 1; o >>= 1) v += __shfl_xor(v, o);
    return v;
}
__device__ __forceinline__ int opaque_tid() { int t = threadIdx.x; asm volatile("" : "+v"(t)); return t; }
template <int CTRL> __device__ __forceinline__ float dppf(float x) { return __builtin_bit_cast(float, __builtin_amdgcn_mov_dpp(__builtin_bit_cast(int, x), CTRL, 0xf, 0xf, true)); }
__device__ __forceinline__ float red8(float x) { x += dppf<0xB1>(x); x += dppf<0x4E>(x); x += dppf<0x141>(x); return x; }

namespace pg8 {
constexpr int BM = 256, BK = 64, HALF = 128, HTB = HALF * BK * 2, STAGE_BYTES = 8 * HTB, NXCD = 8, WGM = 8;
__device__ __forceinline__ int lds_byte(int r, int c) { const int st = (r >> 4) * 2 + (c >> 5), rr = r & 15, cc = c & 31, ob = rr * 64 + cc * 2; return st * 1024 + (ob ^ (((ob >> 9) & 1) << 5)); }
__device__ __forceinline__ void stage_rc(int b, int& R, int& C) { const int st = b / 1024, sb = b % 1024, swz = sb ^ (((sb >> 9) & 1) << 5); R = (st >> 1) * 16 + swz / 64; C = (st & 1) * 32 + (swz % 64) / 2; }
__device__ __forceinline__ int perm32(int rho) { const int n = rho >> 4, i = rho & 15; return 8 * (i >> 2) + 4 * n + (i & 3); }

struct Unit { int pm, pn; };
struct Gemm { const bf16_t* A; const bf16_t* Bt; int K, lda, ldb, acol; };

struct StaticOrder {
    int nM, nN, nwg, G, c;
    __device__ void init(int M, int N, int G_, int c_) { nM = M / BM; nN = N / BM; nwg = nM * nN; G = G_; c = c_; }
    __device__ bool next(int i, Unit& u) const {
        const long L = (long)i * G + c; if (L >= nwg) return false;
        int wgid = (int)L; { const int q = nwg / NXCD, r = nwg % NXCD, xcd = wgid % NXCD, off = wgid / NXCD; wgid = (xcd < r ? xcd * (q + 1) : r * (q + 1) + (xcd - r) * q) + off; }
        const int nig = WGM * nN, gid = wgid / nig, fm = gid * WGM, gsz = (nM - fm) < WGM ? (nM - fm) : WGM;
        u.pm = fm + ((wgid % nig) % gsz); u.pn = (wgid % nig) / gsz; return true;
    }
};

struct EpiF32 {
    static constexpr bool PERM = false;
    float* C; int ldc; const float* scale;
    __device__ __forceinline__ void operator()(const f32x4 (&acc)[2][2][4][2], const Unit& u, int wr, int wc, int fr, int fq) const {
        const int row0 = u.pm * BM + wr * 64 + fr, col0 = u.pn * BM + wc * 32 + 4 * fq;
        f32x4 sv[2][2];
#pragma unroll
        for (int bj = 0; bj < 2; ++bj)
#pragma unroll
            for (int n = 0; n < 2; ++n) sv[bj][n] = scale ? *(const f32x4*)(scale + col0 + bj * HALF + n * 16) : (f32x4){1.f, 1.f, 1.f, 1.f};
#pragma unroll
        for (int ai = 0; ai < 2; ++ai)
#pragma unroll
            for (int m = 0; m < 4; ++m) { float* rowp = C + (size_t)(row0 + ai * HALF + m * 16) * ldc + col0;
#pragma unroll
                for (int bj = 0; bj < 2; ++bj)
#pragma unroll
                    for (int n = 0; n < 2; ++n) *(f32x4*)(rowp + bj * HALF + n * 16) = acc[ai][bj][m][n] * sv[bj][n]; }
    }
};
struct EpiBf16 {
    static constexpr bool PERM = true;
    bf16_t* O; int ldc;
    __device__ __forceinline__ void operator()(const f32x4 (&acc)[2][2][4][2], const Unit& u, int wr, int wc, int fr, int fq) const {
        const int row0 = u.pm * BM + wr * 64 + fr, col0 = u.pn * BM + wc * 32 + 8 * fq;
#pragma unroll
        for (int ai = 0; ai < 2; ++ai)
#pragma unroll
            for (int m = 0; m < 4; ++m) { bf16_t* rowp = O + (size_t)(row0 + ai * HALF + m * 16) * ldc + col0;
#pragma unroll
                for (int bj = 0; bj < 2; ++bj) { const f32x4 v0 = acc[ai][bj][m][0], v1 = acc[ai][bj][m][1];
                    u32x4 w; w.x = cvt_pk_bf16(v0[0], v0[1]); w.y = cvt_pk_bf16(v0[2], v0[3]); w.z = cvt_pk_bf16(v1[0], v1[1]); w.w = cvt_pk_bf16(v1[2], v1[3]);
                    *(u32x4*)(rowp + bj * HALF) = w; } }
    }
};
struct EpiSwiGLU {
    static constexpr bool PERM = true;
    bf16_t* O; int ldc;
    __device__ __forceinline__ void operator()(const f32x4 (&acc)[2][2][4][2], const Unit& u, int wr, int wc, int fr, int fq) const {
        const int row0 = u.pm * BM + wr * 64 + fr, col0 = u.pn * HALF + wc * 32 + 8 * fq;
#pragma unroll
        for (int ai = 0; ai < 2; ++ai)
#pragma unroll
            for (int m = 0; m < 4; ++m) { bf16_t* rowp = O + (size_t)(row0 + ai * HALF + m * 16) * ldc + col0;
                const f32x4 g0 = acc[ai][0][m][0], g1 = acc[ai][0][m][1], u0 = acc[ai][1][m][0], u1 = acc[ai][1][m][1];
                u32x4 w; w.x = cvt_pk_bf16(silu_f(g0[0]) * u0[0], silu_f(g0[1]) * u0[1]); w.y = cvt_pk_bf16(silu_f(g0[2]) * u0[2], silu_f(g0[3]) * u0[3]);
                w.z = cvt_pk_bf16(silu_f(g1[0]) * u1[0], silu_f(g1[1]) * u1[1]); w.w = cvt_pk_bf16(silu_f(g1[2]) * u1[2], silu_f(g1[3]) * u1[3]);
                *(u32x4*)rowp = w; }
    }
};

template <class Epi, class Sched>
__device__ __forceinline__ void gemm_phase(LAS unsigned char* lds, const Gemm g, const Sched& S, const Epi& E) {
    const int tid = opaque_tid(), wid = __builtin_amdgcn_readfirstlane(tid >> 6), lane = tid & 63, wr = wid >> 2, wc = wid & 3, fr = lane & 15, fq = lane >> 4;
    const int K = g.K, nt = K / BK;
    unsigned voffA[2], voffB[2];
#pragma unroll
    for (int i = 0; i < 2; ++i) { int R, C; stage_rc(tid * 16 + i * 8192, R, C); const int Rb = Epi::PERM ? ((R & ~31) + perm32(R & 31)) : R;
        voffA[i] = (unsigned)(R * g.lda + C) * 2u; voffB[i] = (unsigned)(Rb * g.ldb + C) * 2u; }
    const size_t kstep = (size_t)(BK * 2);
    const size_t hstepA = (size_t)HALF * g.lda * 2, hstepB = (size_t)HALF * g.ldb * 2;
    const size_t tstepA = 2 * hstepA, tstepB = 2 * hstepB;
    const unsigned ldsw = (unsigned)wid * 1024u;
    const int aoff = lds_byte(wr * 64 + fr, fq * 8), boff = lds_byte(wc * 32 + fr, fq * 8);
#define PG8_SA(b, h) (((b) * 2 + (h)) * HTB)
#define PG8_SB(b, h) ((4 + (b) * 2 + (h)) * HTB)
#define PG8_STAGE(bufoff, gbase, voff) do { _Pragma("unroll") for (int _i = 0; _i < 2; ++_i) \
        __builtin_amdgcn_global_load_lds((const unsigned*)((const char*)(gbase) + (voff)[_i]), (LAS unsigned*)(lds + (bufoff) + ldsw + _i * 8192), 16, 0, 0); } while (0)
#define PG8_LDA(dst, b, h) do { _Pragma("unroll") for (int m = 0; m < 4; ++m) _Pragma("unroll") for (int k = 0; k < 2; ++k) dst[m][k] = *(const LAS bf16x8*)(lds + PG8_SA(b, h) + aoff + m * 2048 + k * 1024); } while (0)
#define PG8_LDB(dst, b, h) do { _Pragma("unroll") for (int n = 0; n < 2; ++n) _Pragma("unroll") for (int k = 0; k < 2; ++k) dst[n][k] = *(const LAS bf16x8*)(lds + PG8_SB(b, h) + boff + n * 2048 + k * 1024); } while (0)
#define PG8_MMA(ai, bj, At, Bt) do { __builtin_amdgcn_s_setprio(1); _Pragma("unroll") for (int m = 0; m < 4; ++m) _Pragma("unroll") for (int n = 0; n < 2; ++n) _Pragma("unroll") for (int k = 0; k < 2; ++k) \
        acc[ai][bj][m][n] = __builtin_amdgcn_mfma_f32_16x16x32_bf16(Bt[n][k], At[m][k], acc[ai][bj][m][n], 0, 0, 0); __builtin_amdgcn_s_setprio(0); } while (0)
#define PG8_WAIT_V(n) asm volatile("s_waitcnt vmcnt(" #n ")" ::: "memory")
#define PG8_WAIT_L(n) asm volatile("s_waitcnt lgkmcnt(" #n ")" ::: "memory")
#define PG8_BAR __builtin_amdgcn_s_barrier()
#define PG8_SCHED __builtin_amdgcn_sched_barrier(0)
    Unit cur, nxt; int ui = 0;
    if (!S.next(0, cur)) return;
    f32x4 acc[2][2][4][2];
#pragma unroll
    for (int a = 0; a < 2; ++a)
#pragma unroll
        for (int b = 0; b < 2; ++b)
#pragma unroll
            for (int m = 0; m < 4; ++m)
#pragma unroll
                for (int n = 0; n < 2; ++n) acc[a][b][m][n] = (f32x4){0.f, 0.f, 0.f, 0.f};
    bf16x8 At[4][2], B0[2][2], B1[2][2];
    const char* cA = (const char*)g.A + (size_t)cur.pm * tstepA + (size_t)cur.pn * g.acol * 2; const char* cB = (const char*)g.Bt + (size_t)cur.pn * tstepB;
    PG8_STAGE(PG8_SB(0, 0), cB, voffB); PG8_STAGE(PG8_SA(0, 0), cA, voffA); PG8_STAGE(PG8_SB(0, 1), cB + hstepB, voffB); PG8_STAGE(PG8_SA(0, 1), cA + hstepA, voffA);
    if (wr == 1) PG8_BAR;
    PG8_WAIT_V(4); PG8_BAR;
    PG8_STAGE(PG8_SB(1, 0), cB + kstep, voffB); PG8_STAGE(PG8_SA(1, 0), cA + kstep, voffA); PG8_STAGE(PG8_SB(1, 1), cB + hstepB + kstep, voffB);
    PG8_WAIT_V(6); PG8_BAR;
    for (;;) {
        const bool has_next = S.next(ui + 1, nxt);
        const char* nA = has_next ? (const char*)g.A + (size_t)nxt.pm * tstepA + (size_t)nxt.pn * g.acol * 2 : cA; const char* nB = has_next ? (const char*)g.Bt + (size_t)nxt.pn * tstepB : cB;
        for (int t = 0; t < nt; t += 2) {
            const bool last = (t == nt - 2);
            const char* a1 = cA + (size_t)(t + 1) * kstep;
            const char* a2 = last ? nA : cA + (size_t)(t + 2) * kstep; const char* b2 = last ? nB : cB + (size_t)(t + 2) * kstep;
            const char* a3 = a2 + kstep; const char* b3 = b2 + kstep;
            PG8_LDB(B0, 0, 0); PG8_SCHED; PG8_LDA(At, 0, 0); PG8_STAGE(PG8_SA(1, 1), a1 + hstepA, voffA);
            PG8_WAIT_L(8); PG8_BAR; PG8_WAIT_L(0); PG8_MMA(0, 0, At, B0); PG8_BAR; PG8_SCHED;
            PG8_LDB(B1, 0, 1); PG8_STAGE(PG8_SB(0, 0), b2, voffB);
            PG8_BAR; PG8_WAIT_L(0); PG8_MMA(0, 1, At, B1); PG8_BAR;
            PG8_LDA(At, 0, 1); PG8_STAGE(PG8_SA(0, 0), a2, voffA);
            PG8_BAR; PG8_WAIT_L(0); PG8_MMA(1, 0, At, B0); PG8_BAR; PG8_SCHED;
            PG8_STAGE(PG8_SB(0, 1), b2 + hstepB, voffB);
            PG8_WAIT_V(6); PG8_BAR; PG8_MMA(1, 1, At, B1); PG8_BAR;
            PG8_LDB(B0, 1, 0); PG8_SCHED; PG8_LDA(At, 1, 0); PG8_STAGE(PG8_SA(0, 1), a2 + hstepA, voffA);
            PG8_WAIT_L(8); PG8_BAR; PG8_WAIT_L(0); PG8_MMA(0, 0, At, B0); PG8_BAR; PG8_SCHED;
            PG8_LDB(B1, 1, 1); PG8_STAGE(PG8_SB(1, 0), b3, voffB);
            PG8_BAR; PG8_WAIT_L(0); PG8_MMA(0, 1, At, B1); PG8_BAR;
            PG8_LDA(At, 1, 1); PG8_STAGE(PG8_SA(1, 0), a3, voffA);
            PG8_BAR; PG8_WAIT_L(0); PG8_MMA(1, 0, At, B0); PG8_BAR; PG8_SCHED;
            PG8_STAGE(PG8_SB(1, 1), b3 + hstepB, voffB);
            PG8_WAIT_V(6); PG8_BAR; PG8_MMA(1, 1, At, B1); PG8_BAR;
        }
        E(acc, cur, wr, wc, fr, fq);
        if (!has_next) break;
#pragma unroll
        for (int a = 0; a < 2; ++a)
#pragma unroll
            for (int b = 0; b < 2; ++b)
#pragma unroll
                for (int m = 0; m < 4; ++m)
#pragma unroll
                    for (int n = 0; n < 2; ++n) acc[a][b][m][n] = (f32x4){0.f, 0.f, 0.f, 0.f};
        cur = nxt; cA = nA; cB = nB; ++ui;
    }
    PG8_WAIT_V(0);
    if (wr == 0) PG8_BAR;
    PG8_BAR;
#undef PG8_SA
#undef PG8_SB
#undef PG8_STAGE
#undef PG8_LDA
#undef PG8_LDB
#undef PG8_MMA
#undef PG8_WAIT_V
#undef PG8_WAIT_L
#undef PG8_BAR
#undef PG8_SCHED
}
}

constexpr int CT_GU = 8 * 16 * 88, CT_DN = 8 * 44 * 16, CT_IN = 2 * 16 * 100, CT_OUT = 2 * 32 * 16, CT_POOL = 8 * 4 * 4;
constexpr int CT_TOTAL = CT_GU + CT_DN + CT_IN + CT_OUT + CT_POOL;

__device__ __forceinline__ void convert_weights(LAS float* tile, const Params& P) {
    const int tid = opaque_tid();
    for (int t = blockIdx.x; t < CT_TOTAL; t += gridDim.x) {
        const float* src; int ldsrc, k0, n0, nvalid, lddst, dstrow0; bf16_t* dst;
        if (t < CT_GU) { const int l = t / 1408, rem = t % 1408, kt = rem % 16, rt = rem / 16, r0 = rt * 64, pn = r0 >> 8, bj = (r0 >> 7) & 1, j0 = r0 & 127;
            src = (bj ? P.w_up : P.w_gate) + (size_t)l * D * FF; ldsrc = FF; k0 = kt * 64; n0 = 128 * pn + j0; nvalid = FF; dst = (bf16_t*)(P.ws + WS_WGU + l * SZ_WGU); lddst = D; dstrow0 = r0; }
        else if (t < CT_GU + CT_DN) { const int tt = t - CT_GU, l = tt / 704, rem = tt % 704, kt = rem % 44, nt_ = rem / 44;
            src = P.w_down + (size_t)l * FF * D; ldsrc = D; k0 = kt * 64; n0 = nt_ * 64; nvalid = D; dst = (bf16_t*)(P.ws + WS_WDN + l * SZ_WDN); lddst = FF; dstrow0 = n0; }
        else if (t < CT_GU + CT_DN + CT_IN) { const int tt = t - CT_GU - CT_DN, l = tt / 1600, rem = tt % 1600, kt = rem % 16, nt_ = rem / 16;
            src = P.dn_w_in + (size_t)l * D * IN_DIM; ldsrc = IN_DIM; k0 = kt * 64; n0 = nt_ * 64; nvalid = IN_DIM; dst = (bf16_t*)(P.ws + WS_WIN + l * SZ_WIN); lddst = D; dstrow0 = n0; }
        else if (t < CT_GU + CT_DN + CT_IN + CT_OUT) { const int tt = t - CT_GU - CT_DN - CT_IN, l = tt / 512, rem = tt % 512, kt = rem % 32, nt_ = rem / 32;
            src = P.dn_w_out + (size_t)l * VAL_DIM * D; ldsrc = D; k0 = kt * 64; n0 = nt_ * 64; nvalid = D; dst = (bf16_t*)(P.ws + WS_WOUT + l * SZ_WOUT); lddst = VAL_DIM; dstrow0 = n0; }
        else { const int tt = t - CT_GU - CT_DN - CT_IN - CT_OUT, mtx = tt / 16, rem = tt % 16, kt = rem % 4, nt_ = rem / 4;
            src = P.pool_w + (size_t)mtx * 65536; ldsrc = 256; k0 = kt * 64; n0 = nt_ * 64; nvalid = 256; dst = (bf16_t*)(P.ws + WS_WPOOL) + (size_t)mtx * 65536; lddst = 256; dstrow0 = n0; }
        {   const int rr = tid >> 4, c4 = tid & 15, n = n0 + c4 * 4;
#pragma unroll
            for (int h = 0; h < 2; ++h) { const int k = rr + h * 32;
                f32x4 v = (f32x4){0.f, 0.f, 0.f, 0.f};
                if (n < nvalid) v = *(const f32x4*)(src + (size_t)(k0 + k) * ldsrc + n);
                LAS float* tp = tile + k * 65 + c4 * 4; tp[0] = v[0]; tp[1] = v[1]; tp[2] = v[2]; tp[3] = v[3]; }
        }
        __syncthreads();
        {   const int n = tid >> 3, kg = tid & 7; const LAS float* tp = tile + (kg * 8) * 65 + n;
            u32x4 w; w.x = cvt_pk_bf16(tp[0], tp[65]); w.y = cvt_pk_bf16(tp[130], tp[195]); w.z = cvt_pk_bf16(tp[260], tp[325]); w.w = cvt_pk_bf16(tp[390], tp[455]);
            *(u32x4*)(dst + (size_t)(dstrow0 + n) * lddst + k0 + kg * 8) = w;
        }
        __syncthreads();
    }
}

__device__ __forceinline__ void row_pass(const Params& P, int mode, float coef, const float* gpost, const float* gnext, int pool_j) {
    const int tid = opaque_tid(), lane = tid & 63, wv = tid >> 6;
    float* X = P.out + O_Y; const float* Y = (const float*)(P.ws + WS_Y); bf16_t* HN = (bf16_t*)(P.ws + WS_HN);
    for (int row = blockIdx.x * 8 + wv; row < T; row += gridDim.x * 8) {
        f32x4 x[4];
        if (mode == 0) { const float* src = row < TP ? P.x_prompt + (size_t)row * D : P.x_sample + (size_t)(row - TP) * D;
#pragma unroll
            for (int i = 0; i < 4; ++i) x[i] = *(const f32x4*)(src + i * 256 + lane * 4); }
        else { f32x4 y[4]; float ss = 0.f;
#pragma unroll
            for (int i = 0; i < 4; ++i) { y[i] = *(const f32x4*)(Y + (size_t)row * D + i * 256 + lane * 4); x[i] = *(const f32x4*)(X + (size_t)row * D + i * 256 + lane * 4);
                ss += y[i][0] * y[i][0] + y[i][1] * y[i][1] + y[i][2] * y[i][2] + y[i][3] * y[i][3]; }
            ss = wave_sum(ss); const float r = coef * __builtin_amdgcn_rsqf(ss * (1.0f / D) + EPS);
#pragma unroll
            for (int i = 0; i < 4; ++i) { const f32x4 gp = *(const f32x4*)(gpost + i * 256 + lane * 4); x[i] += y[i] * gp * r; } }
#pragma unroll
        for (int i = 0; i < 4; ++i) *(f32x4*)(X + (size_t)row * D + i * 256 + lane * 4) = x[i];
        if (gnext) { float ss = 0.f;
#pragma unroll
            for (int i = 0; i < 4; ++i) ss += x[i][0] * x[i][0] + x[i][1] * x[i][1] + x[i][2] * x[i][2] + x[i][3] * x[i][3];
            ss = wave_sum(ss); const float r = __builtin_amdgcn_rsqf(ss * (1.0f / D) + EPS);
            float* pdst = nullptr;
            if (pool_j >= 0) { if (row < TP) { const int b = row / SEQ, s = row % SEQ; if (s >= SEQ - 15) pdst = P.out + O_POOLP + ((size_t)(pool_j * NB + b) * 15 + (s - (SEQ - 15))) * D; }
                               else { const int b = (row - TP) / DS, s = (row - TP) % DS; pdst = P.out + O_POOLS + ((size_t)(pool_j * DB + b) * 15 + 11 + s) * D; } }
#pragma unroll
            for (int i = 0; i < 4; ++i) { const f32x4 gn = *(const f32x4*)(gnext + i * 256 + lane * 4); const f32x4 h = x[i] * gn * r;
                u32x2 w; w.x = cvt_pk_bf16(h[0], h[1]); w.y = cvt_pk_bf16(h[2], h[3]); *(u32x2*)(HN + (size_t)row * D + i * 256 + lane * 4) = w;
                if (pdst) *(f32x4*)(pdst + i * 256 + lane * 4) = h; } }
    }
}

template <int W> __device__ __forceinline__ void pool_prompt_item(const bf16_t* HN, bf16_t* PO, int row, int col) {
    const int s = row % SEQ; const int n = (s + 1 < W) ? s + 1 : W;
    u32x4 v[W];
#pragma unroll
    for (int i = 0; i < W; ++i) { v[i] = (u32x4){0u, 0u, 0u, 0u}; if (i < n) v[i] = *(const u32x4*)(HN + (size_t)(row - i) * D + col); }
    float a[8];
#pragma unroll
    for (int q = 0; q < 8; ++q) a[q] = 0.f;
#pragma unroll
    for (int i = 0; i < W; ++i) { a[0] += bflo(v[i].x); a[1] += bfhi(v[i].x); a[2] += bflo(v[i].y); a[3] += bfhi(v[i].y); a[4] += bflo(v[i].z); a[5] += bfhi(v[i].z); a[6] += bflo(v[i].w); a[7] += bfhi(v[i].w); }
    const float ic = 1.0f / (float)n; const u32x4 self = v[0];
    u32x4 o; o.x = cvt_pk_bf16(a[0] * ic - bflo(self.x), a[1] * ic - bfhi(self.x)); o.y = cvt_pk_bf16(a[2] * ic - bflo(self.y), a[3] * ic - bfhi(self.y));
    o.z = cvt_pk_bf16(a[4] * ic - bflo(self.z), a[5] * ic - bfhi(self.z)); o.w = cvt_pk_bf16(a[6] * ic - bflo(self.w), a[7] * ic - bfhi(self.w));
    *(u32x4*)(PO + (size_t)row * D + col) = o;
}
__device__ __forceinline__ void pool_pass(const Params& P, int j) {
    const bf16_t* HN = (const bf16_t*)(P.ws + WS_HN); bf16_t* PO = (bf16_t*)(P.ws + WS_H);
    const float* past = P.state_pool + (size_t)j * DB * 15 * D;
    const size_t gtid = (size_t)blockIdx.x * NTHREADS + opaque_tid(), gsz = (size_t)gridDim.x * NTHREADS;
    for (size_t it = gtid; it < (size_t)T * 128; it += gsz) {
        const int c32 = (int)(it & 31), g = (int)((it >> 6) & 3), row = (int)(it >> 8) * 2 + (int)((it >> 5) & 1), col = g * 256 + c32 * 8, w = 2 << g;
        if (row < TP) { if (g == 0) pool_prompt_item<2>(HN, PO, row, col); else if (g == 1) pool_prompt_item<4>(HN, PO, row, col); else if (g == 2) pool_prompt_item<8>(HN, PO, row, col); else pool_prompt_item<16>(HN, PO, row, col); }
        else { const int b = (row - TP) / DS, s = (row - TP) % DS;
            float a[8];
#pragma unroll
            for (int q = 0; q < 8; ++q) a[q] = 0.f;
            const u32x4 self = *(const u32x4*)(HN + (size_t)row * D + col);
            for (int i = 0; i < w; ++i) {
                if (s - i >= 0) { const u32x4 v = *(const u32x4*)(HN + (size_t)(row - i) * D + col);
                    a[0] += bflo(v.x); a[1] += bfhi(v.x); a[2] += bflo(v.y); a[3] += bfhi(v.y); a[4] += bflo(v.z); a[5] += bfhi(v.z); a[6] += bflo(v.w); a[7] += bfhi(v.w); }
                else { const float* pp = past + ((size_t)b * 15 + (15 + s - i)) * D + col; const f32x4 v0 = *(const f32x4*)pp, v1 = *(const f32x4*)(pp + 4);
                    a[0] += v0[0]; a[1] += v0[1]; a[2] += v0[2]; a[3] += v0[3]; a[4] += v1[0]; a[5] += v1[1]; a[6] += v1[2]; a[7] += v1[3]; } }
            const float ic = 1.0f / (float)w;
            u32x4 o; o.x = cvt_pk_bf16(a[0] * ic - bflo(self.x), a[1] * ic - bfhi(self.x)); o.y = cvt_pk_bf16(a[2] * ic - bflo(self.y), a[3] * ic - bfhi(self.y));
            o.z = cvt_pk_bf16(a[4] * ic - bflo(self.z), a[5] * ic - bfhi(self.z)); o.w = cvt_pk_bf16(a[6] * ic - bflo(self.w), a[7] * ic - bfhi(self.w));
            *(u32x4*)(PO + (size_t)row * D + col) = o; }
    }
    float* dst = P.out + O_POOLS + (size_t)j * DB * 15 * D;
    for (size_t it = gtid; it < (size_t)DB * 11 * (D / 4); it += gsz) { const int b = (int)(it / (11 * 256)), r = (int)(it % (11 * 256)), p = r / 256, c4 = r % 256;
        *(f32x4*)(dst + ((size_t)b * 15 + p) * D + c4 * 4) = *(const f32x4*)(past + ((size_t)b * 15 + p + 4) * D + c4 * 4); }
}

constexpr int TB = 32;
constexpr int C_VF = 0, C_QF = 16384, C_KF = 32768, C_KB = 49152, C_QB = 57856, C_S0T = 66560, C_RAW = 101376, C_KDT = 101376, C_DT = 111616, C_PB = 121856, C_AM = 124416,
              C_Z = 128512, C_CW = 136704, C_GBK = 142848, C_BA = 143360;
constexpr int PK = 136, PT = 40;
constexpr int RAW_PIECES = (TB + 3) * 48;
__device__ __forceinline__ int seg_col(int seg, int hk, int hv) { return seg == 0 ? hk * 128 : (seg == 1 ? 1024 + hk * 128 : 2048 + hv * 128); }
__device__ __forceinline__ void delta_fetch(const bf16_t* proj, const float* cpast, bool isPrompt, int row0, int ntok, int t0, int hk, int hv, int tid, u32x4 (&rr)[4], u32x4& rz, unsigned& rba) {
#pragma unroll
    for (int i = 0; i < 4; ++i) { const int p = tid + NTHREADS * i; rr[i] = (u32x4){0u, 0u, 0u, 0u};
        if (p < RAW_PIECES) { const int r = p / 48, q48 = p % 48, seg = q48 >> 4, l16 = q48 & 15, tt = t0 - 3 + r, col = seg_col(seg, hk, hv) + l16 * 8;
            if (tt >= 0) { if (tt < ntok) rr[i] = *(const u32x4*)(proj + (size_t)(row0 + tt) * IN_PAD + col); }
            else if (!isPrompt) { const float* f = cpast + (3 + tt) * CONV_DIM + col; const f32x4 a = *(const f32x4*)f, c = *(const f32x4*)(f + 4);
                rr[i] = (u32x4){cvt_pk_bf16(a[0], a[1]), cvt_pk_bf16(a[2], a[3]), cvt_pk_bf16(c[0], c[1]), cvt_pk_bf16(c[2], c[3])}; } } }
    {   const int r = tid >> 4, l16 = tid & 15, tt = t0 + r; rz = (u32x4){0u, 0u, 0u, 0u};
        if (tt < ntok) rz = *(const u32x4*)(proj + (size_t)(row0 + tt) * IN_PAD + 4096 + hv * 128 + l16 * 8); }
    rba = 0u;
    if (tid < 2 * TB) { const int r = tid >> 1, tt = t0 + r; if (tt < ntok) rba = proj[(size_t)(row0 + tt) * IN_PAD + 6144 + (tid & 1) * 16 + hv]; }
}
#define MFMA16(X, Y, ACC) __builtin_amdgcn_mfma_f32_16x16x32_bf16((X), (Y), (ACC), 0, 0, 0)
__device__ __forceinline__ void delta_item(LAS unsigned char* LB, const Params& P, int j, bool isPrompt, int b, int hv) {
    const int tid0 = opaque_tid(), hk = hv >> 1;
    LAS float* Vf = (LAS float*)(LB + C_VF); LAS float* qf = (LAS float*)(LB + C_QF); LAS float* kf = (LAS float*)(LB + C_KF); LAS float* Rf = qf; LAS float* Of = kf;
    LAS bf16_t* Kb = (LAS bf16_t*)(LB + C_KB); LAS bf16_t* Qb = (LAS bf16_t*)(LB + C_QB); LAS bf16_t* S0T = (LAS bf16_t*)(LB + C_S0T);
    LAS bf16_t* KdT = (LAS bf16_t*)(LB + C_KDT); LAS bf16_t* DT = (LAS bf16_t*)(LB + C_DT); LAS bf16_t* Pb = (LAS bf16_t*)(LB + C_PB); LAS float* Am = (LAS float*)(LB + C_AM);
    LAS float* gbk = (LAS float*)(LB + C_GBK); LAS float* cw = (LAS float*)(LB + C_CW); LAS bf16_t* raw = (LAS bf16_t*)(LB + C_RAW); LAS bf16_t* zr = (LAS bf16_t*)(LB + C_Z); LAS bf16_t* ba = (LAS bf16_t*)(LB + C_BA);
    const bf16_t* proj = (const bf16_t*)(P.ws + WS_PROJ); bf16_t* OG = (bf16_t*)(P.ws + WS_H);
    const float* conv_w = P.dn_conv_w + (size_t)j * 4 * CONV_DIM; const float* normw = P.dn_norm_w + j * 128;
    const float alog = P.dn_a_log[j * HV + hv], dtb = P.dn_dt_bias[j * HV + hv];
    const int row0 = isPrompt ? b * SEQ : TP + b * DS, ntok = isPrompt ? SEQ : DS;
    const float* cpast = P.state_conv + (size_t)(j * DB + b) * 3 * CONV_DIM;
    u32x4 rr[4], rz; unsigned rba;
    delta_fetch(proj, cpast, isPrompt, row0, ntok, 0, hk, hv, tid0, rr, rz, rba);
    for (int idx = tid0; idx < 4 * 384; idx += NTHREADS) { const int jj = idx / 384, ch = idx % 384; cw[idx] = conv_w[jj * CONV_DIM + seg_col(ch >> 7, hk, hv) + (ch & 127)]; }
    f32x4 Sacc[8];
    { const int lane = tid0 & 63, wv = tid0 >> 6, fr = lane & 15, fq = lane >> 4;
    if (isPrompt) {
#pragma unroll
        for (int dm = 0; dm < 8; ++dm) Sacc[dm] = (f32x4){0.f, 0.f, 0.f, 0.f}; }
    else { const float* s0 = P.state_delta + ((size_t)(j * DB + b) * HV + hv) * 16384 + 16 * wv + fr;
#pragma unroll
        for (int dm = 0; dm < 8; ++dm)
#pragma unroll
            for (int r = 0; r < 4; ++r) Sacc[dm][r] = s0[(16 * dm + 4 * fq + r) * 128]; } }
    const f32x2 nw = *(const f32x2*)(normw + (tid0 & 63) * 2);
    const float nalog = -__expf(alog);
    for (int t0 = 0; t0 < ntok; t0 += TB) {
        const int nb = (ntok - t0) < TB ? (ntok - t0) : TB;
        int tid = tid0; asm volatile("" : "+v"(tid));
        const int lane = tid & 63, wv = __builtin_amdgcn_readfirstlane(tid >> 6), fr = lane & 15, fq = lane >> 4;
#pragma unroll
        for (int i = 0; i < 4; ++i) { const int p = tid + NTHREADS * i; if (p < RAW_PIECES) *(LAS u32x4*)(raw + p * 8) = rr[i]; }
        *(LAS u32x4*)(zr + tid * 8) = rz;
        if (tid < 2 * TB) ba[tid] = (bf16_t)rba;
        __syncthreads();
        if (t0 + TB < ntok) delta_fetch(proj, cpast, isPrompt, row0, ntok, t0 + TB, hk, hv, tid, rr, rz, rba);
        for (int idx = tid; idx < TB * 384; idx += NTHREADS) {
            const int tok = idx / 384, ch = idx % 384, part = ch >> 7;
            float acc = 0.f;
#pragma unroll
            for (int jj = 0; jj < 4; ++jj) acc += bf2f(raw[(tok + jj) * 384 + ch]) * cw[jj * 384 + ch];
            LAS float* dstp = part == 0 ? qf : (part == 1 ? kf : Vf);
            dstp[tok * 128 + (ch & 127)] = tok < nb ? silu_f(acc) : 0.f;
        }
        if (wv == 0) { float g = 0.f, beta = 0.f;
            if (lane < nb) { const float bb = bf2f(ba[lane * 2]), aa = bf2f(ba[lane * 2 + 1]) + dtb; const float sp = aa > 20.f ? aa : log1pf(__expf(aa)); g = nalog * sp; beta = 1.0f / (1.0f + __expf(-bb)); }
            float gc = g;
#pragma unroll
            for (int o = 1; o < 32; o <<= 1) { const float t = __shfl_up(gc, o); if (lane >= o) gc += t; }
            if (lane < 32) *(LAS f32x4*)(gbk + lane * 4) = (f32x4){g, beta, gc, __expf(gc)}; }
        __syncthreads();
        {   const float GcLast = gbk[31 * 4 + 2];
            f32x2 q[4], k[4]; float sq[4], sk[4];
#pragma unroll
            for (int u = 0; u < 4; ++u) { const int tok = wv + 8 * u; q[u] = *(LAS f32x2*)(qf + tok * 128 + lane * 2); k[u] = *(LAS f32x2*)(kf + tok * 128 + lane * 2);
                sq[u] = q[u].x * q[u].x + q[u].y * q[u].y; sk[u] = k[u].x * k[u].x + k[u].y * k[u].y; }
#pragma unroll
            for (int o = 32; o >= 1; o >>= 1)
#pragma unroll
                for (int u = 0; u < 4; ++u) { sq[u] += __shfl_xor(sq[u], o); sk[u] += __shfl_xor(sk[u], o); }
#pragma unroll
            for (int u = 0; u < 4; ++u) { const int tok = wv + 8 * u;
                const float rq = __builtin_amdgcn_rsqf(sq[u] + EPS) * 0.08838834764831845f, rk = __builtin_amdgcn_rsqf(sk[u] + EPS);
                const f32x2 qn = q[u] * rq, kn = k[u] * rk;
                *(LAS unsigned*)(Qb + tok * PK + lane * 2) = cvt_pk_bf16(qn.x, qn.y); *(LAS unsigned*)(Kb + tok * PK + lane * 2) = cvt_pk_bf16(kn.x, kn.y);
                const float dk = __expf(GcLast - gbk[tok * 4 + 2]); const unsigned kd = cvt_pk_bf16(kn.x * dk, kn.y * dk);
                KdT[(2 * lane) * PT + tok] = (bf16_t)(kd & 0xffffu); KdT[(2 * lane + 1) * PT + tok] = (bf16_t)(kd >> 16); }
#pragma unroll
            for (int dm = 0; dm < 8; ++dm) { u32x2 w; w.x = cvt_pk_bf16(Sacc[dm][0], Sacc[dm][1]); w.y = cvt_pk_bf16(Sacc[dm][2], Sacc[dm][3]);
                *(LAS u32x2*)(S0T + (16 * wv + fr) * PK + 16 * dm + 4 * fq) = w; }
        }
        __syncthreads();
        f32x4 accO[2];
        {   f32x4 acc1[4];
#pragma unroll
            for (int mi = 0; mi < 4; ++mi) acc1[mi] = (f32x4){0.f, 0.f, 0.f, 0.f};
#pragma unroll
            for (int ks = 0; ks < 4; ++ks) { const bf16x8 Y = *(const LAS bf16x8*)(S0T + (16 * wv + fr) * PK + 32 * ks + 8 * fq);
#pragma unroll
                for (int mi = 0; mi < 4; ++mi) { const bf16x8 X = *(const LAS bf16x8*)((mi < 2 ? Kb : Qb) + (16 * (mi & 1) + fr) * PK + 32 * ks + 8 * fq); acc1[mi] = MFMA16(X, Y, acc1[mi]); } }
            f32x4 acc2 = (f32x4){0.f, 0.f, 0.f, 0.f};
            {   const LAS bf16_t* Xb = (wv < 4 ? Kb : Qb) + (16 * ((wv >> 1) & 1) + fr) * PK; const LAS bf16_t* Yb = Kb + (16 * (wv & 1) + fr) * PK;
#pragma unroll
                for (int ks = 0; ks < 4; ++ks) acc2 = MFMA16(*(const LAS bf16x8*)(Xb + 32 * ks + 8 * fq), *(const LAS bf16x8*)(Yb + 32 * ks + 8 * fq), acc2); }
            {   const int ib = 16 * ((wv >> 1) & 1) + 4 * fq, jc = 16 * (wv & 1) + fr; const float Gj = gbk[jc * 4 + 2];
#pragma unroll
                for (int r = 0; r < 4; ++r) { const int i = ib + r; const f32x4 gi = *(const LAS f32x4*)(gbk + i * 4);
                    if (wv < 4) Am[i * 32 + jc] = (jc < i) ? gi[1] * __expf(gi[2] - Gj) * acc2[r] : 0.f;
                    else { const float pv = (jc <= i) ? __expf(gi[2] - Gj) * acc2[r] : 0.f; Pb[i * PT + jc] = (bf16_t)(cvt_pk_bf16(pv, 0.f) & 0xffffu); } } }
#pragma unroll
            for (int mi = 0; mi < 2; ++mi)
#pragma unroll
                for (int r = 0; r < 4; ++r) { const int i = 16 * mi + 4 * fq + r, e = 16 * wv + fr; const f32x4 gi = *(const LAS f32x4*)(gbk + i * 4);
                    Rf[i * 128 + e] = gi[1] * (Vf[i * 128 + e] - gi[3] * acc1[mi][r]); accO[mi][r] = gi[3] * acc1[2 + mi][r]; }
        }
        __syncthreads();
        if (tid < 128) { float dl[32];
            LAS float* Amo = Am; const LAS float* Rfo = Rf + tid; asm volatile("" : "+v"(Amo), "+v"(Rfo));
#pragma unroll
            for (int i = 0; i < 32; ++i) { float acc = Rfo[i * 128];
#pragma unroll
                for (int j4 = 0; j4 < (i + 3) / 4; ++j4) { const f32x4 a4 = *(const LAS f32x4*)(Amo + i * 32 + 4 * j4);
#pragma unroll
                    for (int jj = 0; jj < 4; ++jj) if (4 * j4 + jj < i) acc -= a4[jj] * dl[4 * j4 + jj]; }
                asm volatile("" : "+v"(acc) :: "memory"); dl[i] = acc; }
#pragma unroll
            for (int q8 = 0; q8 < 4; ++q8) { u32x4 w; w.x = cvt_pk_bf16(dl[8 * q8], dl[8 * q8 + 1]); w.y = cvt_pk_bf16(dl[8 * q8 + 2], dl[8 * q8 + 3]); w.z = cvt_pk_bf16(dl[8 * q8 + 4], dl[8 * q8 + 5]); w.w = cvt_pk_bf16(dl[8 * q8 + 6], dl[8 * q8 + 7]);
                *(LAS u32x4*)(DT + tid * PT + 8 * q8) = w; } }
        __syncthreads();
        {   const bf16x8 Y = *(const LAS bf16x8*)(DT + (16 * wv + fr) * PT + 8 * fq);
#pragma unroll
            for (int mi = 0; mi < 2; ++mi) { const bf16x8 X = *(const LAS bf16x8*)(Pb + (16 * mi + fr) * PT + 8 * fq); accO[mi] = MFMA16(X, Y, accO[mi]);
#pragma unroll
                for (int r = 0; r < 4; ++r) Of[(16 * mi + 4 * fq + r) * 128 + 16 * wv + fr] = accO[mi][r]; }
            const float aL = gbk[31 * 4 + 3];
#pragma unroll
            for (int dm = 0; dm < 8; ++dm) { const bf16x8 X = *(const LAS bf16x8*)(KdT + (16 * dm + fr) * PT + 8 * fq); Sacc[dm] = MFMA16(X, Y, Sacc[dm] * aL); }
        }
        __syncthreads();
        {   f32x2 o[4]; float ss[4];
#pragma unroll
            for (int u = 0; u < 4; ++u) { o[u] = *(const LAS f32x2*)(Of + (wv + 8 * u) * 128 + lane * 2); ss[u] = o[u].x * o[u].x + o[u].y * o[u].y; }
#pragma unroll
            for (int of = 32; of >= 1; of >>= 1)
#pragma unroll
                for (int u = 0; u < 4; ++u) ss[u] += __shfl_xor(ss[u], of);
#pragma unroll
            for (int u = 0; u < 4; ++u) { const int tok = wv + 8 * u;
                if (tok < nb) { const float r = __builtin_amdgcn_rsqf(ss[u] * (1.0f / 128.f) + EPS); const unsigned zz = *(const LAS unsigned*)(zr + tok * 128 + lane * 2);
                    *(unsigned*)(OG + (size_t)(row0 + t0 + tok) * VAL_DIM + hv * 128 + lane * 2) = cvt_pk_bf16(o[u].x * r * nw.x * silu_f(bflo(zz)), o[u].y * r * nw.y * silu_f(bfhi(zz))); } }
        }
        __syncthreads();
    }
    {   const int lane = tid0 & 63, wv = tid0 >> 6, fr = lane & 15, fq = lane >> 4;
        float* sd = (isPrompt ? P.out + O_DELTAP + ((size_t)(j * NB + b) * HV + hv) * 16384 : P.out + O_DELTAS + ((size_t)(j * DB + b) * HV + hv) * 16384) + 16 * wv + fr;
#pragma unroll
        for (int dm = 0; dm < 8; ++dm)
#pragma unroll
            for (int r = 0; r < 4; ++r) sd[(16 * dm + 4 * fq + r) * 128] = Sacc[dm][r]; }
}
__device__ __forceinline__ void delta_phase(LAS unsigned char* L, const Params& P, int j) {
    const int G = gridDim.x, bid = blockIdx.x;
    const bf16_t* proj = (const bf16_t*)(P.ws + WS_PROJ);
    {
        const size_t gtid = (size_t)bid * NTHREADS + opaque_tid(), gsz = (size_t)G * NTHREADS;
        for (size_t it = gtid; it < (size_t)NB * 3 * CONV_DIM; it += gsz) { const int b = (int)(it / (3 * CONV_DIM)), r = (int)(it % (3 * CONV_DIM)), p = r / CONV_DIM, c = r % CONV_DIM;
            P.out[O_CONVP + (size_t)j * NB * 3 * CONV_DIM + it] = bf2f(proj[(size_t)(b * SEQ + SEQ - 3 + p) * IN_PAD + c]); }
        for (size_t it = gtid; it < (size_t)DB * 3 * CONV_DIM; it += gsz) { const int b = (int)(it / (3 * CONV_DIM)), r = (int)(it % (3 * CONV_DIM)), p = r / CONV_DIM, c = r % CONV_DIM;
            P.out[O_CONVS + (size_t)j * DB * 3 * CONV_DIM + it] = bf2f(proj[(size_t)(TP + b * DS + 1 + p) * IN_PAD + c]); }
    }
    const int nP = NB * HV, nS = DB * HV;
#pragma unroll 1
    for (int k = 0;; ++k) {
        int it;
        if (G >= 2 * nP) { if (bid < nP) { if (k > 0) break; it = bid; } else it = nP + (bid - nP) + k * (G - nP); }
        else it = bid + k * G;
        if (it >= nP + nS) break;
        const bool isPrompt = it < nP; const int ii = isPrompt ? it : it - nP;
        delta_item(L, P, j, isPrompt, ii / HV, ii % HV);
    }
}

#define XB_TMO      128
#define XB_XCNT(j)  (256  + 64 * (j))
#define XB_XSUB(j)  (1280 + 64 * (j))
#define XB_XGEN(j)  (2304 + 64 * (j))
#define XB_TOP      3328
#define XB_TOPGEN   3392
#define XCD_BAR_WORDS 3456
#define XB_SPIN_CAP (1u << 22)
constexpr int LDS_ST_OFF = LDS_BYTES - 64;
__device__ __forceinline__ unsigned xb_ld(unsigned* p)              { return __hip_atomic_load(p, __ATOMIC_RELAXED, __HIP_MEMORY_SCOPE_AGENT); }
__device__ __forceinline__ unsigned xb_add(unsigned* p, unsigned v) { return __hip_atomic_fetch_add(p, v, __ATOMIC_RELAXED, __HIP_MEMORY_SCOPE_AGENT); }
__device__ __forceinline__ unsigned xb_xcc_id() { return (unsigned)__builtin_amdgcn_s_getreg((3 << 11) | 20) & 0xFu; }
#define XB_SPIN(cond, bar) do { unsigned _sp = 0; while (cond) { __builtin_amdgcn_s_sleep(1); \
    if ((++_sp & 255u) == 0u) { if (xb_ld(&(bar)[XB_TMO])) break; if (_sp > XB_SPIN_CAP) { atomicAdd(&(bar)[XB_TMO], 1u); break; } } } } while (0)
__device__ __forceinline__ void xcd_barrier_complete(unsigned* bar, unsigned x, unsigned& nloc, unsigned& nx) {
    const unsigned G = gridDim.x;
    unsigned sum, cnt, mine, sp = 0u;
    for (;;) {
        sum = 0u; cnt = 0u; mine = 0u;
#pragma unroll
        for (unsigned j = 0; j < 16; ++j) { const unsigned c = xb_ld(&bar[XB_XCNT(j)]); sum += c; cnt += (c > 0u) ? 1u : 0u; mine = (j == x) ? c : mine; }
        if (sum == G) break;
        __builtin_amdgcn_s_sleep(1);
        if ((++sp & 255u) == 0u) { if (xb_ld(&bar[XB_TMO])) break; if (sp > XB_SPIN_CAP) { atomicAdd(&bar[XB_TMO], 1u); break; } }
    }
    nloc = mine > 0u ? mine : 1u; nx = cnt > 0u ? cnt : 1u;
}
__device__ __forceinline__ void xcd_barrier(unsigned* bar, volatile LAS unsigned* st) {
    asm volatile("s_waitcnt vmcnt(0)" ::: "memory");
    __syncthreads();
    if (threadIdx.x == 0) {
        const unsigned x = xb_xcc_id();
        __builtin_amdgcn_s_waitcnt(0);
        unsigned nloc = st[0], nx = st[1];
        if (nloc == 0u) { xcd_barrier_complete(bar, x, nloc, nx); st[0] = nloc; st[1] = nx; }
        const unsigned old = xb_add(&bar[XB_XSUB(x)], 1u);
        const unsigned gen = old / nloc;
        if (old + 1u == (gen + 1u) * nloc) {
            __builtin_amdgcn_fence(__ATOMIC_RELEASE, "agent");
            asm volatile("s_waitcnt vmcnt(0)" ::: "memory");
            const unsigned og = xb_add(&bar[XB_TOP], 1u);
            const unsigned tg = og / nx;
            if (og + 1u == (tg + 1u) * nx) xb_add(&bar[XB_TOPGEN], 1u);
            else XB_SPIN(xb_ld(&bar[XB_TOPGEN]) == tg, bar);
            __builtin_amdgcn_fence(__ATOMIC_ACQUIRE, "agent");
            xb_add(&bar[XB_XGEN(x)], 1u);
            asm volatile("s_waitcnt vmcnt(0)" ::: "memory");
        } else {
            XB_SPIN(xb_ld(&bar[XB_XGEN(x)]) == gen, bar);
            __builtin_amdgcn_fence(__ATOMIC_ACQUIRE, "agent");
            asm volatile("s_waitcnt vmcnt(0)" ::: "memory");
        }
    }
    __syncthreads();
}

typedef const __attribute__((address_space(4))) Params* KP;
__device__ __forceinline__ Params ldp(KP kp) {
    asm volatile("" : "+s"(kp));
    Params P;
    P.x_prompt = kp->x_prompt; P.x_sample = kp->x_sample; P.state_pool = kp->state_pool; P.state_conv = kp->state_conv; P.state_delta = kp->state_delta; P.norm_gains = kp->norm_gains;
    P.w_gate = kp->w_gate; P.w_up = kp->w_up; P.w_down = kp->w_down; P.pool_w = kp->pool_w; P.pool_scale = kp->pool_scale; P.dn_w_in = kp->dn_w_in; P.dn_conv_w = kp->dn_conv_w;
    P.dn_a_log = kp->dn_a_log; P.dn_dt_bias = kp->dn_dt_bias; P.dn_norm_w = kp->dn_norm_w; P.dn_w_out = kp->dn_w_out; P.out = kp->out; P.ws = kp->ws;
    return P;
}
__global__ void __launch_bounds__(NTHREADS, 2) mk_fwd(Params Punused) {
    extern __shared__ __attribute__((aligned(16))) unsigned char lds_raw[];
    LAS unsigned char* lds = (LAS unsigned char*)lds_raw;
    cg::grid_group grid = cg::this_grid();
    KP kp = (KP)__builtin_amdgcn_kernarg_segment_ptr();

    {   const Params P = ldp(kp); unsigned* bar = (unsigned*)(P.ws + WS_BAR);
        if (blockIdx.x == 0) for (int i = threadIdx.x; i < XCD_BAR_WORDS; i += NTHREADS) bar[i] = 0u;
        if (threadIdx.x == 0) { ((volatile LAS unsigned*)(lds + LDS_ST_OFF))[0] = 0u; ((volatile LAS unsigned*)(lds + LDS_ST_OFF))[1] = 0u; } }
    { const Params P = ldp(kp); convert_weights((LAS float*)lds, P); }
    { const Params P = ldp(kp); row_pass(P, 0, 0.f, nullptr, P.norm_gains, -1); }
    grid.sync();
    if (threadIdx.x == 0) { const Params P = ldp(kp); (void)xb_add(&((unsigned*)(P.ws + WS_BAR))[XB_XCNT(xb_xcc_id())], 1u); }
#define GBAR() do { const Params Pb = ldp(kp); xcd_barrier((unsigned*)(Pb.ws + WS_BAR), (volatile LAS unsigned*)(lds + LDS_ST_OFF)); } while (0)

#pragma unroll 1
    for (int step = 0; step < 12; ++step) {
        const int layer = step / 3, sub = step % 3, jm = layer >> 1;
        if (sub != 1) {
            const Params P = ldp(kp); const int l = layer * 2 + (sub >> 1);
            pg8::Gemm g{(const bf16_t*)(P.ws + WS_HN), (const bf16_t*)(P.ws + WS_WGU + l * SZ_WGU), D, D, D, 0}; pg8::StaticOrder S; S.init(T, 2 * FF, gridDim.x, blockIdx.x);
            pg8::EpiSwiGLU E{(bf16_t*)(P.ws + WS_H), FF}; pg8::gemm_phase(lds, g, S, E);
        } else if ((layer & 1) == 0) {
            const Params P = ldp(kp); pool_pass(P, jm);
        } else {
            {   const Params P = ldp(kp);
                pg8::Gemm g{(const bf16_t*)(P.ws + WS_HN), (const bf16_t*)(P.ws + WS_WIN + jm * SZ_WIN), D, D, D, 0}; pg8::StaticOrder S; S.init(T, IN_PAD, gridDim.x, blockIdx.x);
                pg8::EpiBf16 E{(bf16_t*)(P.ws + WS_PROJ), IN_PAD}; pg8::gemm_phase(lds, g, S, E); }
            GBAR();
            { const Params P = ldp(kp); delta_phase(lds, P, jm); }
        }
        GBAR();
        {   const Params P = ldp(kp);
            pg8::Gemm gf; const float* fscale = nullptr; const bf16_t* A = (const bf16_t*)(P.ws + WS_H);
            if (sub != 1) { const int l = layer * 2 + (sub >> 1); gf = pg8::Gemm{A, (const bf16_t*)(P.ws + WS_WDN + l * SZ_WDN), FF, FF, FF, 0}; }
            else if ((layer & 1) == 0) { gf = pg8::Gemm{A, (const bf16_t*)(P.ws + WS_WPOOL + jm * SZ_WPOOL), 256, D, 256, 256}; fscale = P.pool_scale + jm * D; }
            else gf = pg8::Gemm{A, (const bf16_t*)(P.ws + WS_WOUT + jm * SZ_WOUT), VAL_DIM, VAL_DIM, VAL_DIM, 0};
            pg8::StaticOrder S; S.init(T, D, gridDim.x, blockIdx.x); pg8::EpiF32 E{(float*)(P.ws + WS_Y), D, fscale}; pg8::gemm_phase(lds, gf, S, E); }
        GBAR();
        {   const Params P = ldp(kp); const float* ng = P.norm_gains + (size_t)layer * 6 * D;
            const float* gpost = ng + (sub == 0 ? 1 : sub == 1 ? 3 : 5) * D;
            const float* gnext = sub == 0 ? ng + 2 * D : sub == 1 ? ng + 4 * D : (layer < 3 ? ng + 6 * D : nullptr);
            row_pass(P, 1, sub == 1 ? 1.0f : 0.5f, gpost, gnext, (sub == 0 && (layer & 1) == 0) ? jm : -1); }
        if (step < 11) GBAR();
    }
}

extern "C" void kernel_launch(void* const* d_in, const int* in_sizes, int n_in, void* d_out, int out_size, void* d_ws, size_t ws_size, hipStream_t stream) {
    static int grid = 0;
    if (grid == 0) {
        int dev = 0, cus = 0, per_cu = 0;
        if (ws_size < WS_END || n_in != 17) { fprintf(stderr, "kernel_launch: need %zu bytes of workspace (got %zu), 17 inputs (got %d)\n", (size_t)WS_END, ws_size, n_in); grid = -1; return; }
        if (hipGetDevice(&dev) != hipSuccess || hipDeviceGetAttribute(&cus, hipDeviceAttributeMultiprocessorCount, dev) != hipSuccess) { grid = -1; return; }
        if (hipFuncSetAttribute((const void*)mk_fwd, hipFuncAttributeMaxDynamicSharedMemorySize, LDS_BYTES) != hipSuccess) { fprintf(stderr, "hipFuncSetAttribute failed\n"); grid = -1; return; }
        if (hipOccupancyMaxActiveBlocksPerMultiprocessor(&per_cu, (const void*)mk_fwd, NTHREADS, LDS_BYTES) != hipSuccess || per_cu < 1) { fprintf(stderr, "occupancy query: %d\n", per_cu); }
        (void)hipGetLastError();
        grid = cus;
    }
    if (grid < 0) return;
    Params p{};
    p.x_prompt = (const float*)d_in[0]; p.x_sample = (const float*)d_in[1]; p.state_pool = (const float*)d_in[2]; p.state_conv = (const float*)d_in[3]; p.state_delta = (const float*)d_in[4];
    p.norm_gains = (const float*)d_in[5]; p.w_gate = (const float*)d_in[6]; p.w_up = (const float*)d_in[7]; p.w_down = (const float*)d_in[8]; p.pool_w = (const float*)d_in[9];
    p.pool_scale = (const float*)d_in[10]; p.dn_w_in = (const float*)d_in[11]; p.dn_conv_w = (const float*)d_in[12]; p.dn_a_log = (const float*)d_in[13]; p.dn_dt_bias = (const float*)d_in[14];
    p.dn_norm_w = (const float*)d_in[15]; p.dn_w_out = (const float*)d_in[16];
    p.out = (float*)d_out; p.ws = (unsigned char*)d_ws;
    void* args[] = {&p};
    hipError_t e = hipLaunchCooperativeKernel((const void*)mk_fwd, dim3(grid), dim3(NTHREADS), args, LDS_BYTES, stream);
    if (e != hipSuccess) fprintf(stderr, "cooperative launch failed: %s (grid %d)\n", hipGetErrorString(e), grid);
}
```

```cpp
#include <hip/hip_runtime.h>
#include <hip/hip_cooperative_groups.h>
#include <cstdio>
namespace cg = cooperative_groups;

#define LAS __attribute__((address_space(3)))
typedef unsigned short bf16_t;
typedef short bf16x8 __attribute__((ext_vector_type(8)));
typedef float f32x4 __attribute__((ext_vector_type(4)));
typedef float f32x2 __attribute__((ext_vector_type(2)));
typedef unsigned u32x4 __attribute__((ext_vector_type(4)));
typedef unsigned u32x2 __attribute__((ext_vector_type(2)));

constexpr int D = 1024, FF = 2816, SEQ = 2048, NB = 8, DB = 128, DS = 4;
constexpr int TP = NB * SEQ, TS = DB * DS, T = TP + TS;
constexpr int CONV_DIM = 4096, IN_DIM = 6176, IN_PAD = 6400, VAL_DIM = 2048, HV = 16;
constexpr float EPS = 1e-6f;
constexpr int NTHREADS = 512;
constexpr int LDS_BYTES = 144 * 1024;

constexpr size_t SZ_WGU = (size_t)2 * FF * D * 2, SZ_WDN = (size_t)D * FF * 2, SZ_WIN = (size_t)IN_PAD * D * 2, SZ_WOUT = (size_t)D * VAL_DIM * 2, SZ_WPOOL = (size_t)D * 256 * 2;
constexpr size_t WS_WGU = 0;
constexpr size_t WS_WDN = WS_WGU + 8 * SZ_WGU;
constexpr size_t WS_WIN = WS_WDN + 8 * SZ_WDN;
constexpr size_t WS_WOUT = WS_WIN + 2 * SZ_WIN;
constexpr size_t WS_WPOOL = WS_WOUT + 2 * SZ_WOUT;
constexpr size_t WS_HN = WS_WPOOL + 2 * SZ_WPOOL;
constexpr size_t WS_H = WS_HN + (size_t)T * D * 2;
constexpr size_t WS_Y = WS_H + (size_t)T * FF * 2;
constexpr size_t WS_PROJ = WS_Y + (size_t)T * D * 4;
constexpr size_t WS_BAR = WS_PROJ + (size_t)T * IN_PAD * 2;
constexpr size_t WS_END = WS_BAR + 16384;

constexpr size_t O_Y = 0;
constexpr size_t O_POOLP = (size_t)T * D;
constexpr size_t O_CONVP = O_POOLP + (size_t)2 * NB * 15 * D;
constexpr size_t O_DELTAP = O_CONVP + (size_t)2 * NB * 3 * CONV_DIM;
constexpr size_t O_POOLS = O_DELTAP + (size_t)2 * NB * HV * 16384;
constexpr size_t O_CONVS = O_POOLS + (size_t)2 * DB * 15 * D;
constexpr size_t O_DELTAS = O_CONVS + (size_t)2 * DB * 3 * CONV_DIM;

struct Params {
    const float* x_prompt; const float* x_sample; const float* state_pool; const float* state_conv; const float* state_delta; const float* norm_gains;
    const float* w_gate; const float* w_up; const float* w_down; const float* pool_w; const float* pool_scale; const float* dn_w_in; const float* dn_conv_w;
    const float* dn_a_log; const float* dn_dt_bias; const float* dn_norm_w; const float* dn_w_out;
    float* out; unsigned char* ws;
};

__device__ __forceinline__ unsigned cvt_pk_bf16(float lo, float hi) { unsigned r; asm volatile("v_cvt_pk_bf16_f32 %0, %1, %2" : "=v"(r) : "v"(lo), "v"(hi)); return r; }
__device__ __forceinline__ float bf2f(bf16_t b) { return __uint_as_float(((unsigned)b) << 16); }
__device__ __forceinline__ float bflo(unsigned w) { return __uint_as_float(w << 16); }
__device__ __forceinline__ float bfhi(unsigned w) { return __uint_as_float(w & 0xffff0000u); }
__device__ __forceinline__ float silu_f(float x) { return x * __builtin_amdgcn_rcpf(1.0f + __builtin_amdgcn_exp2f(-1.44269504089f * x)); }
__device__ __forceinline__ int opaque_tid() { int t = threadIdx.x; asm volatile("" : "+v"(t)); return t; }
template <int CTRL> __device__ __forceinline__ float dppf(float x) { return __builtin_bit_cast(float, __builtin_amdgcn_mov_dpp(__builtin_bit_cast(int, x), CTRL, 0xf, 0xf, true)); }
__device__ __forceinline__ float red8(float x) { x += dppf<0xB1>(x); x += dppf<0x4E>(x); x += dppf<0x141>(x); return x; }
__device__ __forceinline__ float rl(float x, int l) { return __builtin_bit_cast(float, __builtin_amdgcn_readlane(__builtin_bit_cast(int, x), l)); }
__device__ __forceinline__ float wave_sum(float x) {
    x = red8(x); x += dppf<0x140>(x);
    return (rl(x, 0) + rl(x, 16)) + (rl(x, 32) + rl(x, 48));
}

namespace pg8 {
constexpr int BM = 256, BK = 64, HALF = 128, HTB = HALF * BK * 2, STAGE_BYTES = 8 * HTB, NXCD = 8, WGM = 8;
__device__ __forceinline__ int lds_byte(int r, int c) { const int st = (r >> 4) * 2 + (c >> 5), rr = r & 15, cc = c & 31, ob = rr * 64 + cc * 2; return st * 1024 + (ob ^ (((ob >> 9) & 1) << 5)); }
__device__ __forceinline__ void stage_rc(int b, int& R, int& C) { const int st = b / 1024, sb = b % 1024, swz = sb ^ (((sb >> 9) & 1) << 5); R = (st >> 1) * 16 + swz / 64; C = (st & 1) * 32 + (swz % 64) / 2; }
__device__ __forceinline__ int perm32(int rho) { const int n = rho >> 4, i = rho & 15; return 8 * (i >> 2) + 4 * n + (i & 3); }

struct Unit { int pm, pn; };
struct Gemm { const bf16_t* A; const bf16_t* Bt; int K, lda, ldb, acol; };

struct StaticOrder {
    int nM, nN, nwg, G, c;
    __device__ void init(int M, int N, int G_, int c_) { nM = M / BM; nN = N / BM; nwg = nM * nN; G = G_; c = c_; }
    __device__ bool next(int i, Unit& u) const {
        const long L = (long)i * G + c; if (L >= nwg) return false;
        int wgid = (int)L; { const int q = nwg / NXCD, r = nwg % NXCD, xcd = wgid % NXCD, off = wgid / NXCD; wgid = (xcd < r ? xcd * (q + 1) : r * (q + 1) + (xcd - r) * q) + off; }
        const int nig = WGM * nN, gid = wgid / nig, fm = gid * WGM, gsz = (nM - fm) < WGM ? (nM - fm) : WGM;
        u.pm = fm + ((wgid % nig) % gsz); u.pn = (wgid % nig) / gsz; return true;
    }
};

struct EpiF32 {
    static constexpr bool PERM = false;
    float* C; int ldc; const float* scale;
    __device__ __forceinline__ void operator()(const f32x4 (&acc)[2][2][4][2], const Unit& u, int wr, int wc, int fr, int fq) const {
        const int row0 = u.pm * BM + wr * 64 + fr, col0 = u.pn * BM + wc * 32 + 4 * fq;
        f32x4 sv[2][2];
#pragma unroll
        for (int bj = 0; bj < 2; ++bj)
#pragma unroll
            for (int n = 0; n < 2; ++n) sv[bj][n] = scale ? *(const f32x4*)(scale + col0 + bj * HALF + n * 16) : (f32x4){1.f, 1.f, 1.f, 1.f};
#pragma unroll
        for (int ai = 0; ai < 2; ++ai)
#pragma unroll
            for (int m = 0; m < 4; ++m) { float* rowp = C + (size_t)(row0 + ai * HALF + m * 16) * ldc + col0;
#pragma unroll
                for (int bj = 0; bj < 2; ++bj)
#pragma unroll
                    for (int n = 0; n < 2; ++n) *(f32x4*)(rowp + bj * HALF + n * 16) = acc[ai][bj][m][n] * sv[bj][n]; }
    }
};
struct EpiBf16 {
    static constexpr bool PERM = true;
    bf16_t* O; int ldc;
    __device__ __forceinline__ void operator()(const f32x4 (&acc)[2][2][4][2], const Unit& u, int wr, int wc, int fr, int fq) const {
        const int row0 = u.pm * BM + wr * 64 + fr, col0 = u.pn * BM + wc * 32 + 8 * fq;
#pragma unroll
        for (int ai = 0; ai < 2; ++ai)
#pragma unroll
            for (int m = 0; m < 4; ++m) { bf16_t* rowp = O + (size_t)(row0 + ai * HALF + m * 16) * ldc + col0;
#pragma unroll
                for (int bj = 0; bj < 2; ++bj) { const f32x4 v0 = acc[ai][bj][m][0], v1 = acc[ai][bj][m][1];
                    u32x4 w; w.x = cvt_pk_bf16(v0[0], v0[1]); w.y = cvt_pk_bf16(v0[2], v0[3]); w.z = cvt_pk_bf16(v1[0], v1[1]); w.w = cvt_pk_bf16(v1[2], v1[3]);
                    *(u32x4*)(rowp + bj * HALF) = w; } }
    }
};
struct EpiSwiGLU {
    static constexpr bool PERM = true;
    bf16_t* O; int ldc;
    __device__ __forceinline__ void operator()(const f32x4 (&acc)[2][2][4][2], const Unit& u, int wr, int wc, int fr, int fq) const {
        const int row0 = u.pm * BM + wr * 64 + fr, col0 = u.pn * HALF + wc * 32 + 8 * fq;
#pragma unroll
        for (int ai = 0; ai < 2; ++ai)
#pragma unroll
            for (int m = 0; m < 4; ++m) { bf16_t* rowp = O + (size_t)(row0 + ai * HALF + m * 16) * ldc + col0;
                const f32x4 g0 = acc[ai][0][m][0], g1 = acc[ai][0][m][1], u0 = acc[ai][1][m][0], u1 = acc[ai][1][m][1];
                u32x4 w; w.x = cvt_pk_bf16(silu_f(g0[0]) * u0[0], silu_f(g0[1]) * u0[1]); w.y = cvt_pk_bf16(silu_f(g0[2]) * u0[2], silu_f(g0[3]) * u0[3]);
                w.z = cvt_pk_bf16(silu_f(g1[0]) * u1[0], silu_f(g1[1]) * u1[1]); w.w = cvt_pk_bf16(silu_f(g1[2]) * u1[2], silu_f(g1[3]) * u1[3]);
                *(u32x4*)rowp = w; }
    }
};

template <class Epi, class Sched>
__device__ __forceinline__ void gemm_phase(LAS unsigned char* lds, const Gemm g, const Sched& S, const Epi& E) {
    const int tid = opaque_tid(), wid = __builtin_amdgcn_readfirstlane(tid >> 6), lane = tid & 63, wr = wid >> 2, wc = wid & 3, fr = lane & 15, fq = lane >> 4;
    const int K = g.K, nt = K / BK;
    unsigned voffA[2], voffB[2];
#pragma unroll
    for (int i = 0; i < 2; ++i) { int R, C; stage_rc(tid * 16 + i * 8192, R, C); const int Rb = Epi::PERM ? ((R & ~31) + perm32(R & 31)) : R;
        voffA[i] = (unsigned)(R * g.lda + C) * 2u; voffB[i] = (unsigned)(Rb * g.ldb + C) * 2u; }
    const size_t kstep = (size_t)(BK * 2);
    const size_t hstepA = (size_t)HALF * g.lda * 2, hstepB = (size_t)HALF * g.ldb * 2;
    const size_t tstepA = 2 * hstepA, tstepB = 2 * hstepB;
    const unsigned ldsw = (unsigned)wid * 1024u;
    const int aoff = lds_byte(wr * 64 + fr, fq * 8), boff = lds_byte(wc * 32 + fr, fq * 8);
#define PG8_SA(b, h) (((b) * 2 + (h)) * HTB)
#define PG8_SB(b, h) ((4 + (b) * 2 + (h)) * HTB)
#define PG8_STAGE(bufoff, gbase, voff) do { _Pragma("unroll") for (int _i = 0; _i < 2; ++_i) \
        __builtin_amdgcn_global_load_lds((const unsigned*)((const char*)(gbase) + (voff)[_i]), (LAS unsigned*)(lds + (bufoff) + ldsw + _i * 8192), 16, 0, 0); } while (0)
#define PG8_LDA(dst, b, h) do { _Pragma("unroll") for (int m = 0; m < 4; ++m) _Pragma("unroll") for (int k = 0; k < 2; ++k) dst[m][k] = *(const LAS bf16x8*)(lds + PG8_SA(b, h) + aoff + m * 2048 + k * 1024); } while (0)
#define PG8_LDB(dst, b, h) do { _Pragma("unroll") for (int n = 0; n < 2; ++n) _Pragma("unroll") for (int k = 0; k < 2; ++k) dst[n][k] = *(const LAS bf16x8*)(lds + PG8_SB(b, h) + boff + n * 2048 + k * 1024); } while (0)
#define PG8_MMA(ai, bj, At, Bt) do { __builtin_amdgcn_s_setprio(1); _Pragma("unroll") for (int m = 0; m < 4; ++m) _Pragma("unroll") for (int n = 0; n < 2; ++n) _Pragma("unroll") for (int k = 0; k < 2; ++k) \
        acc[ai][bj][m][n] = __builtin_amdgcn_mfma_f32_16x16x32_bf16(Bt[n][k], At[m][k], acc[ai][bj][m][n], 0, 0, 0); __builtin_amdgcn_s_setprio(0); } while (0)
#define PG8_WAIT_V(n) asm volatile("s_waitcnt vmcnt(" #n ")" ::: "memory")
#define PG8_WAIT_L(n) asm volatile("s_waitcnt lgkmcnt(" #n ")" ::: "memory")
#define PG8_BAR __builtin_amdgcn_s_barrier()
#define PG8_SCHED __builtin_amdgcn_sched_barrier(0)
    Unit cur, nxt; int ui = 0;
    if (!S.next(0, cur)) return;
    f32x4 acc[2][2][4][2];
#pragma unroll
    for (int a = 0; a < 2; ++a)
#pragma unroll
        for (int b = 0; b < 2; ++b)
#pragma unroll
            for (int m = 0; m < 4; ++m)
#pragma unroll
                for (int n = 0; n < 2; ++n) acc[a][b][m][n] = (f32x4){0.f, 0.f, 0.f, 0.f};
    bf16x8 At[4][2], B0[2][2], B1[2][2];
    const char* cA = (const char*)g.A + (size_t)cur.pm * tstepA + (size_t)cur.pn * g.acol * 2; const char* cB = (const char*)g.Bt + (size_t)cur.pn * tstepB;
    PG8_STAGE(PG8_SB(0, 0), cB, voffB); PG8_STAGE(PG8_SA(0, 0), cA, voffA); PG8_STAGE(PG8_SB(0, 1), cB + hstepB, voffB); PG8_STAGE(PG8_SA(0, 1), cA + hstepA, voffA);
    if (wr == 1) PG8_BAR;
    PG8_WAIT_V(4); PG8_BAR;
    PG8_STAGE(PG8_SB(1, 0), cB + kstep, voffB); PG8_STAGE(PG8_SA(1, 0), cA + kstep, voffA); PG8_STAGE(PG8_SB(1, 1), cB + hstepB + kstep, voffB);
    PG8_WAIT_V(6); PG8_BAR;
    for (;;) {
        const bool has_next = S.next(ui + 1, nxt);
        const char* nA = has_next ? (const char*)g.A + (size_t)nxt.pm * tstepA + (size_t)nxt.pn * g.acol * 2 : cA; const char* nB = has_next ? (const char*)g.Bt + (size_t)nxt.pn * tstepB : cB;
        for (int t = 0; t < nt; t += 2) {
            const bool last = (t == nt - 2);
            const char* a1 = cA + (size_t)(t + 1) * kstep;
            const char* a2 = last ? nA : cA + (size_t)(t + 2) * kstep; const char* b2 = last ? nB : cB + (size_t)(t + 2) * kstep;
            const char* a3 = a2 + kstep; const char* b3 = b2 + kstep;
            PG8_LDB(B0, 0, 0); PG8_SCHED; PG8_LDA(At, 0, 0); PG8_STAGE(PG8_SA(1, 1), a1 + hstepA, voffA);
            PG8_WAIT_L(8); PG8_BAR; PG8_WAIT_L(0); PG8_MMA(0, 0, At, B0); PG8_BAR; PG8_SCHED;
            PG8_LDB(B1, 0, 1); PG8_STAGE(PG8_SB(0, 0), b2, voffB);
            PG8_BAR; PG8_WAIT_L(0); PG8_MMA(0, 1, At, B1); PG8_BAR;
            PG8_LDA(At, 0, 1); PG8_STAGE(PG8_SA(0, 0), a2, voffA);
            PG8_BAR; PG8_WAIT_L(0); PG8_MMA(1, 0, At, B0); PG8_BAR; PG8_SCHED;
            PG8_STAGE(PG8_SB(0, 1), b2 + hstepB, voffB);
            PG8_WAIT_V(6); PG8_BAR; PG8_MMA(1, 1, At, B1); PG8_BAR;
            PG8_LDB(B0, 1, 0); PG8_SCHED; PG8_LDA(At, 1, 0); PG8_STAGE(PG8_SA(0, 1), a2 + hstepA, voffA);
            PG8_WAIT_L(8); PG8_BAR; PG8_WAIT_L(0); PG8_MMA(0, 0, At, B0); PG8_BAR; PG8_SCHED;
            PG8_LDB(B1, 1, 1); PG8_STAGE(PG8_SB(1, 0), b3, voffB);
            PG8_BAR; PG8_WAIT_L(0); PG8_MMA(0, 1, At, B1); PG8_BAR;
            PG8_LDA(At, 1, 1); PG8_STAGE(PG8_SA(1, 0), a3, voffA);
            PG8_BAR; PG8_WAIT_L(0); PG8_MMA(1, 0, At, B0); PG8_BAR; PG8_SCHED;
            PG8_STAGE(PG8_SB(1, 1), b3 + hstepB, voffB);
            PG8_WAIT_V(6); PG8_BAR; PG8_MMA(1, 1, At, B1); PG8_BAR;
        }
        E(acc, cur, wr, wc, fr, fq);
        if (!has_next) break;
#pragma unroll
        for (int a = 0; a < 2; ++a)
#pragma unroll
            for (int b = 0; b < 2; ++b)
#pragma unroll
                for (int m = 0; m < 4; ++m)
#pragma unroll
                    for (int n = 0; n < 2; ++n) acc[a][b][m][n] = (f32x4){0.f, 0.f, 0.f, 0.f};
        cur = nxt; cA = nA; cB = nB; ++ui;
    }
    PG8_WAIT_V(0);
    if (wr == 0) PG8_BAR;
    PG8_BAR;
#undef PG8_SA
#undef PG8_SB
#undef PG8_STAGE
#undef PG8_LDA
#undef PG8_LDB
#undef PG8_MMA
#undef PG8_WAIT_V
#undef PG8_WAIT_L
#undef PG8_BAR
#undef PG8_SCHED
}
}

constexpr int CT_GU = 8 * 16 * 88, CT_DN = 8 * 44 * 16, CT_IN = 2 * 16 * 100, CT_OUT = 2 * 32 * 16, CT_POOL = 8 * 4 * 4;
constexpr int CT_TOTAL = CT_GU + CT_DN + CT_IN + CT_OUT + CT_POOL;

__device__ __forceinline__ void convert_weights(LAS float* tile, const Params& P) {
    const int tid = opaque_tid();
    for (int t = blockIdx.x; t < CT_TOTAL; t += gridDim.x) {
        const float* src; int ldsrc, k0, n0, nvalid, lddst, dstrow0; bf16_t* dst;
        if (t < CT_GU) { const int l = t / 1408, rem = t % 1408, kt = rem % 16, rt = rem / 16, r0 = rt * 64, pn = r0 >> 8, bj = (r0 >> 7) & 1, j0 = r0 & 127;
            src = (bj ? P.w_up : P.w_gate) + (size_t)l * D * FF; ldsrc = FF; k0 = kt * 64; n0 = 128 * pn + j0; nvalid = FF; dst = (bf16_t*)(P.ws + WS_WGU + l * SZ_WGU); lddst = D; dstrow0 = r0; }
        else if (t < CT_GU + CT_DN) { const int tt = t - CT_GU, l = tt / 704, rem = tt % 704, kt = rem % 44, nt_ = rem / 44;
            src = P.w_down + (size_t)l * FF * D; ldsrc = D; k0 = kt * 64; n0 = nt_ * 64; nvalid = D; dst = (bf16_t*)(P.ws + WS_WDN + l * SZ_WDN); lddst = FF; dstrow0 = n0; }
        else if (t < CT_GU + CT_DN + CT_IN) { const int tt = t - CT_GU - CT_DN, l = tt / 1600, rem = tt % 1600, kt = rem % 16, nt_ = rem / 16;
            src = P.dn_w_in + (size_t)l * D * IN_DIM; ldsrc = IN_DIM; k0 = kt * 64; n0 = nt_ * 64; nvalid = IN_DIM; dst = (bf16_t*)(P.ws + WS_WIN + l * SZ_WIN); lddst = D; dstrow0 = n0; }
        else if (t < CT_GU + CT_DN + CT_IN + CT_OUT) { const int tt = t - CT_GU - CT_DN - CT_IN, l = tt / 512, rem = tt % 512, kt = rem % 32, nt_ = rem / 32;
            src = P.dn_w_out + (size_t)l * VAL_DIM * D; ldsrc = D; k0 = kt * 64; n0 = nt_ * 64; nvalid = D; dst = (bf16_t*)(P.ws + WS_WOUT + l * SZ_WOUT); lddst = VAL_DIM; dstrow0 = n0; }
        else { const int tt = t - CT_GU - CT_DN - CT_IN - CT_OUT, mtx = tt / 16, rem = tt % 16, kt = rem % 4, nt_ = rem / 4;
            src = P.pool_w + (size_t)mtx * 65536; ldsrc = 256; k0 = kt * 64; n0 = nt_ * 64; nvalid = 256; dst = (bf16_t*)(P.ws + WS_WPOOL) + (size_t)mtx * 65536; lddst = 256; dstrow0 = n0; }
        {   const int rr = tid >> 4, c4 = tid & 15, n = n0 + c4 * 4;
#pragma unroll
            for (int h = 0; h < 2; ++h) { const int k = rr + h * 32;
                f32x4 v = (f32x4){0.f, 0.f, 0.f, 0.f};
                if (n < nvalid) v = *(const f32x4*)(src + (size_t)(k0 + k) * ldsrc + n);
                LAS float* tp = tile + k * 65 + c4 * 4; tp[0] = v[0]; tp[1] = v[1]; tp[2] = v[2]; tp[3] = v[3]; }
        }
        __syncthreads();
        {   const int n = tid >> 3, kg = tid & 7; const LAS float* tp = tile + (kg * 8) * 65 + n;
            u32x4 w; w.x = cvt_pk_bf16(tp[0], tp[65]); w.y = cvt_pk_bf16(tp[130], tp[195]); w.z = cvt_pk_bf16(tp[260], tp[325]); w.w = cvt_pk_bf16(tp[390], tp[455]);
            *(u32x4*)(dst + (size_t)(dstrow0 + n) * lddst + k0 + kg * 8) = w;
        }
        __syncthreads();
    }
}

__device__ __forceinline__ void row_pass(const Params& P, int mode, float coef, const float* gpost, const float* gnext, int pool_j) {
    const int tid = opaque_tid(), lane = tid & 63, wv = tid >> 6;
    float* X = P.out + O_Y; const float* Y = (const float*)(P.ws + WS_Y); bf16_t* HN = (bf16_t*)(P.ws + WS_HN);
    for (int row = blockIdx.x * 8 + wv; row < T; row += gridDim.x * 8) {
        f32x4 x[4];
        if (mode == 0) { const float* src = row < TP ? P.x_prompt + (size_t)row * D : P.x_sample + (size_t)(row - TP) * D;
#pragma unroll
            for (int i = 0; i < 4; ++i) x[i] = *(const f32x4*)(src + i * 256 + lane * 4); }
        else { f32x4 y[4]; float ss = 0.f;
#pragma unroll
            for (int i = 0; i < 4; ++i) { y[i] = *(const f32x4*)(Y + (size_t)row * D + i * 256 + lane * 4); x[i] = *(const f32x4*)(X + (size_t)row * D + i * 256 + lane * 4);
                ss += y[i][0] * y[i][0] + y[i][1] * y[i][1] + y[i][2] * y[i][2] + y[i][3] * y[i][3]; }
            ss = wave_sum(ss); const float r = coef * __builtin_amdgcn_rsqf(ss * (1.0f / D) + EPS);
#pragma unroll
            for (int i = 0; i < 4; ++i) { const f32x4 gp = *(const f32x4*)(gpost + i * 256 + lane * 4); x[i] += y[i] * gp * r; } }
#pragma unroll
        for (int i = 0; i < 4; ++i) *(f32x4*)(X + (size_t)row * D + i * 256 + lane * 4) = x[i];
        if (gnext) { float ss = 0.f;
#pragma unroll
            for (int i = 0; i < 4; ++i) ss += x[i][0] * x[i][0] + x[i][1] * x[i][1] + x[i][2] * x[i][2] + x[i][3] * x[i][3];
            ss = wave_sum(ss); const float r = __builtin_amdgcn_rsqf(ss * (1.0f / D) + EPS);
            float* pdst = nullptr;
            if (pool_j >= 0) { if (row < TP) { const int b = row / SEQ, s = row % SEQ; if (s >= SEQ - 15) pdst = P.out + O_POOLP + ((size_t)(pool_j * NB + b) * 15 + (s - (SEQ - 15))) * D; }
                               else { const int b = (row - TP) / DS, s = (row - TP) % DS; pdst = P.out + O_POOLS + ((size_t)(pool_j * DB + b) * 15 + 11 + s) * D; } }
#pragma unroll
            for (int i = 0; i < 4; ++i) { const f32x4 gn = *(const f32x4*)(gnext + i * 256 + lane * 4); const f32x4 h = x[i] * gn * r;
                u32x2 w; w.x = cvt_pk_bf16(h[0], h[1]); w.y = cvt_pk_bf16(h[2], h[3]); *(u32x2*)(HN + (size_t)row * D + i * 256 + lane * 4) = w;
                if (pdst) *(f32x4*)(pdst + i * 256 + lane * 4) = h; } }
    }
}

template <int W> __device__ __forceinline__ void pool_prompt_item(const bf16_t* HN, bf16_t* PO, int row, int col) {
    const int s = row % SEQ; const int n = (s + 1 < W) ? s + 1 : W;
    u32x4 v[W];
#pragma unroll
    for (int i = 0; i < W; ++i) { v[i] = (u32x4){0u, 0u, 0u, 0u}; if (i < n) v[i] = *(const u32x4*)(HN + (size_t)(row - i) * D + col); }
    float a[8];
#pragma unroll
    for (int q = 0; q < 8; ++q) a[q] = 0.f;
#pragma unroll
    for (int i = 0; i < W; ++i) { a[0] += bflo(v[i].x); a[1] += bfhi(v[i].x); a[2] += bflo(v[i].y); a[3] += bfhi(v[i].y); a[4] += bflo(v[i].z); a[5] += bfhi(v[i].z); a[6] += bflo(v[i].w); a[7] += bfhi(v[i].w); }
    const float ic = 1.0f / (float)n; const u32x4 self = v[0];
    u32x4 o; o.x = cvt_pk_bf16(a[0] * ic - bflo(self.x), a[1] * ic - bfhi(self.x)); o.y = cvt_pk_bf16(a[2] * ic - bflo(self.y), a[3] * ic - bfhi(self.y));
    o.z = cvt_pk_bf16(a[4] * ic - bflo(self.z), a[5] * ic - bfhi(self.z)); o.w = cvt_pk_bf16(a[6] * ic - bflo(self.w), a[7] * ic - bfhi(self.w));
    *(u32x4*)(PO + (size_t)row * D + col) = o;
}
__device__ __forceinline__ void pool_pass(const Params& P, int j) {
    const bf16_t* HN = (const bf16_t*)(P.ws + WS_HN); bf16_t* PO = (bf16_t*)(P.ws + WS_H);
    const float* past = P.state_pool + (size_t)j * DB * 15 * D;
    const size_t gtid = (size_t)blockIdx.x * NTHREADS + opaque_tid(), gsz = (size_t)gridDim.x * NTHREADS;
    for (size_t it = gtid; it < (size_t)T * 128; it += gsz) {
        const int c32 = (int)(it & 31), g = (int)((it >> 6) & 3), row = (int)(it >> 8) * 2 + (int)((it >> 5) & 1), col = g * 256 + c32 * 8, w = 2 << g;
        if (row < TP) { if (g == 0) pool_prompt_item<2>(HN, PO, row, col); else if (g == 1) pool_prompt_item<4>(HN, PO, row, col); else if (g == 2) pool_prompt_item<8>(HN, PO, row, col); else pool_prompt_item<16>(HN, PO, row, col); }
        else { const int b = (row - TP) / DS, s = (row - TP) % DS;
            float a[8];
#pragma unroll
            for (int q = 0; q < 8; ++q) a[q] = 0.f;
            const u32x4 self = *(const u32x4*)(HN + (size_t)row * D + col);
            for (int i = 0; i < w; ++i) {
                if (s - i >= 0) { const u32x4 v = *(const u32x4*)(HN + (size_t)(row - i) * D + col);
                    a[0] += bflo(v.x); a[1] += bfhi(v.x); a[2] += bflo(v.y); a[3] += bfhi(v.y); a[4] += bflo(v.z); a[5] += bfhi(v.z); a[6] += bflo(v.w); a[7] += bfhi(v.w); }
                else { const float* pp = past + ((size_t)b * 15 + (15 + s - i)) * D + col; const f32x4 v0 = *(const f32x4*)pp, v1 = *(const f32x4*)(pp + 4);
                    a[0] += v0[0]; a[1] += v0[1]; a[2] += v0[2]; a[3] += v0[3]; a[4] += v1[0]; a[5] += v1[1]; a[6] += v1[2]; a[7] += v1[3]; } }
            const float ic = 1.0f / (float)w;
            u32x4 o; o.x = cvt_pk_bf16(a[0] * ic - bflo(self.x), a[1] * ic - bfhi(self.x)); o.y = cvt_pk_bf16(a[2] * ic - bflo(self.y), a[3] * ic - bfhi(self.y));
            o.z = cvt_pk_bf16(a[4] * ic - bflo(self.z), a[5] * ic - bfhi(self.z)); o.w = cvt_pk_bf16(a[6] * ic - bflo(self.w), a[7] * ic - bfhi(self.w));
            *(u32x4*)(PO + (size_t)row * D + col) = o; }
    }
    float* dst = P.out + O_POOLS + (size_t)j * DB * 15 * D;
    for (size_t it = gtid; it < (size_t)DB * 11 * (D / 4); it += gsz) { const int b = (int)(it / (11 * 256)), r = (int)(it % (11 * 256)), p = r / 256, c4 = r % 256;
        *(f32x4*)(dst + ((size_t)b * 15 + p) * D + c4 * 4) = *(const f32x4*)(past + ((size_t)b * 15 + p + 4) * D + c4 * 4); }
}

constexpr int TB = 32;
constexpr int C_VF = 0, C_QF = 16384, C_KF = 32768, C_KB = 49152, C_QB = 57856, C_S0T = 66560, C_RAW = 101376, C_KDT = 101376, C_DT = 111616, C_PB = 121856, C_AM = 124416,
              C_Z = 128512, C_CW = 136704, C_GBK = 142848, C_BA = 143360;
constexpr int PK = 136, PT = 40;
constexpr int RAW_PIECES = (TB + 3) * 48;
__device__ __forceinline__ int seg_col(int seg, int hk, int hv) { return seg == 0 ? hk * 128 : (seg == 1 ? 1024 + hk * 128 : 2048 + hv * 128); }
__device__ __forceinline__ void delta_fetch(const bf16_t* proj, const float* cpast, bool isPrompt, int row0, int ntok, int t0, int hk, int hv, int tid, u32x4 (&rr)[4], u32x4& rz, unsigned& rba) {
#pragma unroll
    for (int i = 0; i < 4; ++i) { const int p = tid + NTHREADS * i; rr[i] = (u32x4){0u, 0u, 0u, 0u};
        if (p < RAW_PIECES) { const int r = p / 48, q48 = p % 48, seg = q48 >> 4, l16 = q48 & 15, tt = t0 - 3 + r, col = seg_col(seg, hk, hv) + l16 * 8;
            if (tt >= 0) { if (tt < ntok) rr[i] = *(const u32x4*)(proj + (size_t)(row0 + tt) * IN_PAD + col); }
            else if (!isPrompt) { const float* f = cpast + (3 + tt) * CONV_DIM + col; const f32x4 a = *(const f32x4*)f, c = *(const f32x4*)(f + 4);
                rr[i] = (u32x4){cvt_pk_bf16(a[0], a[1]), cvt_pk_bf16(a[2], a[3]), cvt_pk_bf16(c[0], c[1]), cvt_pk_bf16(c[2], c[3])}; } } }
    {   const int r = tid >> 4, l16 = tid & 15, tt = t0 + r; rz = (u32x4){0u, 0u, 0u, 0u};
        if (tt < ntok) rz = *(const u32x4*)(proj + (size_t)(row0 + tt) * IN_PAD + 4096 + hv * 128 + l16 * 8); }
    rba = 0u;
    if (tid < 2 * TB) { const int r = tid >> 1, tt = t0 + r; if (tt < ntok) rba = proj[(size_t)(row0 + tt) * IN_PAD + 6144 + (tid & 1) * 16 + hv]; }
}
#define MFMA16(X, Y, ACC) __builtin_amdgcn_mfma_f32_16x16x32_bf16((X), (Y), (ACC), 0, 0, 0)
__device__ __forceinline__ void delta_item(LAS unsigned char* LB, const Params& P, int j, bool isPrompt, int b, int hv) {
    const int tid0 = opaque_tid(), hk = hv >> 1;
    LAS float* Vf = (LAS float*)(LB + C_VF); LAS float* qf = (LAS float*)(LB + C_QF); LAS float* kf = (LAS float*)(LB + C_KF); LAS float* Rf = qf; LAS float* Of = kf;
    LAS bf16_t* Kb = (LAS bf16_t*)(LB + C_KB); LAS bf16_t* Qb = (LAS bf16_t*)(LB + C_QB); LAS bf16_t* S0T = (LAS bf16_t*)(LB + C_S0T);
    LAS bf16_t* KdT = (LAS bf16_t*)(LB + C_KDT); LAS bf16_t* DT = (LAS bf16_t*)(LB + C_DT); LAS bf16_t* Pb = (LAS bf16_t*)(LB + C_PB); LAS float* Am = (LAS float*)(LB + C_AM);
    LAS float* gbk = (LAS float*)(LB + C_GBK); LAS float* cw = (LAS float*)(LB + C_CW); LAS bf16_t* raw = (LAS bf16_t*)(LB + C_RAW); LAS bf16_t* zr = (LAS bf16_t*)(LB + C_Z); LAS bf16_t* ba = (LAS bf16_t*)(LB + C_BA);
    const bf16_t* proj = (const bf16_t*)(P.ws + WS_PROJ); bf16_t* OG = (bf16_t*)(P.ws + WS_H);
    const float* conv_w = P.dn_conv_w + (size_t)j * 4 * CONV_DIM; const float* normw = P.dn_norm_w + j * 128;
    const float alog = P.dn_a_log[j * HV + hv], dtb = P.dn_dt_bias[j * HV + hv];
    const int row0 = isPrompt ? b * SEQ : TP + b * DS, ntok = isPrompt ? SEQ : DS;
    const float* cpast = P.state_conv + (size_t)(j * DB + b) * 3 * CONV_DIM;
    u32x4 rr[4], rz; unsigned rba;
    delta_fetch(proj, cpast, isPrompt, row0, ntok, 0, hk, hv, tid0, rr, rz, rba);
    for (int idx = tid0; idx < 4 * 384; idx += NTHREADS) { const int jj = idx / 384, ch = idx % 384; cw[idx] = conv_w[jj * CONV_DIM + seg_col(ch >> 7, hk, hv) + (ch & 127)]; }
    f32x4 Sacc[8];
    { const int lane = tid0 & 63, wv = tid0 >> 6, fr = lane & 15, fq = lane >> 4;
    if (isPrompt) {
#pragma unroll
        for (int dm = 0; dm < 8; ++dm) Sacc[dm] = (f32x4){0.f, 0.f, 0.f, 0.f}; }
    else { const float* s0 = P.state_delta + ((size_t)(j * DB + b) * HV + hv) * 16384 + 16 * wv + fr;
#pragma unroll
        for (int dm = 0; dm < 8; ++dm)
#pragma unroll
            for (int r = 0; r < 4; ++r) Sacc[dm][r] = s0[(16 * dm + 4 * fq + r) * 128]; } }
    const f32x2 nw = *(const f32x2*)(normw + (tid0 & 63) * 2);
    const float nalog = -__expf(alog);
    for (int t0 = 0; t0 < ntok; t0 += TB) {
        const int nb = (ntok - t0) < TB ? (ntok - t0) : TB;
        int tid = tid0; asm volatile("" : "+v"(tid));
        const int lane = tid & 63, wv = __builtin_amdgcn_readfirstlane(tid >> 6), fr = lane & 15, fq = lane >> 4;
#pragma unroll
        for (int i = 0; i < 4; ++i) { const int p = tid + NTHREADS * i; if (p < RAW_PIECES) *(LAS u32x4*)(raw + p * 8) = rr[i]; }
        *(LAS u32x4*)(zr + tid * 8) = rz;
        if (tid < 2 * TB) ba[tid] = (bf16_t)rba;
        __syncthreads();
        if (t0 + TB < ntok) delta_fetch(proj, cpast, isPrompt, row0, ntok, t0 + TB, hk, hv, tid, rr, rz, rba);
        {   const int c = tid & 127, tq = tid >> 7;
#pragma unroll
            for (int p = 0; p < 3; ++p) { const LAS bf16_t* rp = raw + (tq * 8) * 384 + p * 128 + c; LAS float* dstp = (p == 0 ? qf : (p == 1 ? kf : Vf)) + (tq * 8) * 128 + c;
                const float w0 = cw[p * 128 + c], w1 = cw[384 + p * 128 + c], w2 = cw[768 + p * 128 + c], w3 = cw[1152 + p * 128 + c];
                float r0 = bf2f(rp[0]), r1 = bf2f(rp[384]), r2 = bf2f(rp[768]);
#pragma unroll
                for (int t = 0; t < 8; ++t) { const float r3 = bf2f(rp[(t + 3) * 384]); const float acc = r0 * w0 + r1 * w1 + r2 * w2 + r3 * w3;
                    dstp[t * 128] = (tq * 8 + t < nb) ? silu_f(acc) : 0.f; r0 = r1; r1 = r2; r2 = r3; } }
        }
        if (wv == 0) { float g = 0.f, beta = 0.f;
            if (lane < nb) { const float bb = bf2f(ba[lane * 2]), aa = bf2f(ba[lane * 2 + 1]) + dtb; const float sp = aa > 20.f ? aa : log1pf(__expf(aa)); g = nalog * sp; beta = 1.0f / (1.0f + __expf(-bb)); }
            float gc = g;
#pragma unroll
            for (int o = 1; o < 32; o <<= 1) { const float t = __shfl_up(gc, o); if (lane >= o) gc += t; }
            if (lane < 32) *(LAS f32x4*)(gbk + lane * 4) = (f32x4){g, beta, gc, __expf(gc)}; }
        __syncthreads();
        {   const float GcLast = gbk[31 * 4 + 2];
            f32x2 q[4], k[4]; float sq[4], sk[4];
#pragma unroll
            for (int u = 0; u < 4; ++u) { const int tok = wv + 8 * u; q[u] = *(LAS f32x2*)(qf + tok * 128 + lane * 2); k[u] = *(LAS f32x2*)(kf + tok * 128 + lane * 2);
                sq[u] = q[u].x * q[u].x + q[u].y * q[u].y; sk[u] = k[u].x * k[u].x + k[u].y * k[u].y; }
#pragma unroll
            for (int u = 0; u < 4; ++u) { sq[u] = wave_sum(sq[u]); sk[u] = wave_sum(sk[u]); }
#pragma unroll
            for (int u = 0; u < 4; ++u) { const int tok = wv + 8 * u;
                const float rq = __builtin_amdgcn_rsqf(sq[u] + EPS) * 0.08838834764831845f, rk = __builtin_amdgcn_rsqf(sk[u] + EPS);
                const f32x2 qn = q[u] * rq, kn = k[u] * rk;
                *(LAS unsigned*)(Qb + tok * PK + lane * 2) = cvt_pk_bf16(qn.x, qn.y); *(LAS unsigned*)(Kb + tok * PK + lane * 2) = cvt_pk_bf16(kn.x, kn.y);
                const float dk = __expf(GcLast - gbk[tok * 4 + 2]); const unsigned kd = cvt_pk_bf16(kn.x * dk, kn.y * dk);
                KdT[(2 * lane) * PT + tok] = (bf16_t)(kd & 0xffffu); KdT[(2 * lane + 1) * PT + tok] = (bf16_t)(kd >> 16); }
#pragma unroll
            for (int dm = 0; dm < 8; ++dm) { u32x2 w; w.x = cvt_pk_bf16(Sacc[dm][0], Sacc[dm][1]); w.y = cvt_pk_bf16(Sacc[dm][2], Sacc[dm][3]);
                *(LAS u32x2*)(S0T + (16 * wv + fr) * PK + 16 * dm + 4 * fq) = w; }
        }
        __syncthreads();
        f32x4 accO[2];
        {   f32x4 acc1[4];
#pragma unroll
            for (int mi = 0; mi < 4; ++mi) acc1[mi] = (f32x4){0.f, 0.f, 0.f, 0.f};
#pragma unroll
            for (int ks = 0; ks < 4; ++ks) { const bf16x8 Y = *(const LAS bf16x8*)(S0T + (16 * wv + fr) * PK + 32 * ks + 8 * fq);
#pragma unroll
                for (int mi = 0; mi < 4; ++mi) { const bf16x8 X = *(const LAS bf16x8*)((mi < 2 ? Kb : Qb) + (16 * (mi & 1) + fr) * PK + 32 * ks + 8 * fq); acc1[mi] = MFMA16(X, Y, acc1[mi]); } }
            f32x4 acc2 = (f32x4){0.f, 0.f, 0.f, 0.f};
            {   const LAS bf16_t* Xb = (wv < 4 ? Kb : Qb) + (16 * ((wv >> 1) & 1) + fr) * PK; const LAS bf16_t* Yb = Kb + (16 * (wv & 1) + fr) * PK;
#pragma unroll
                for (int ks = 0; ks < 4; ++ks) acc2 = MFMA16(*(const LAS bf16x8*)(Xb + 32 * ks + 8 * fq), *(const LAS bf16x8*)(Yb + 32 * ks + 8 * fq), acc2); }
            {   const int ib = 16 * ((wv >> 1) & 1) + 4 * fq, jc = 16 * (wv & 1) + fr; const float Gj = gbk[jc * 4 + 2];
#pragma unroll
                for (int r = 0; r < 4; ++r) { const int i = ib + r; const f32x4 gi = *(const LAS f32x4*)(gbk + i * 4);
                    if (wv < 4) Am[i * 32 + jc] = (jc < i) ? gi[1] * __expf(gi[2] - Gj) * acc2[r] : 0.f;
                    else { const float pv = (jc <= i) ? __expf(gi[2] - Gj) * acc2[r] : 0.f; Pb[i * PT + jc] = (bf16_t)(cvt_pk_bf16(pv, 0.f) & 0xffffu); } } }
#pragma unroll
            for (int mi = 0; mi < 2; ++mi)
#pragma unroll
                for (int r = 0; r < 4; ++r) { const int i = 16 * mi + 4 * fq + r, e = 16 * wv + fr; const f32x4 gi = *(const LAS f32x4*)(gbk + i * 4);
                    Rf[i * 128 + e] = gi[1] * (Vf[i * 128 + e] - gi[3] * acc1[mi][r]); accO[mi][r] = gi[3] * acc1[2 + mi][r]; }
        }
        __syncthreads();
        if (tid < 128) { float dl[32];
            LAS float* Amo = Am; const LAS float* Rfo = Rf + tid; asm volatile("" : "+v"(Amo), "+v"(Rfo));
            f32x4 an[8]; float rn = Rfo[0];
#pragma unroll
            for (int i = 0; i < 32; ++i) { f32x4 ac[8]; float acc = rn;
#pragma unroll
                for (int j4 = 0; j4 < (i + 3) / 4; ++j4) ac[j4] = an[j4];
                if (i < 31) { rn = Rfo[(i + 1) * 128];
#pragma unroll
                    for (int j4 = 0; j4 < (i + 4) / 4; ++j4) an[j4] = *(const LAS f32x4*)(Amo + (i + 1) * 32 + 4 * j4); }
#pragma unroll
                for (int j4 = 0; j4 < (i + 3) / 4; ++j4)
#pragma unroll
                    for (int jj = 0; jj < 4; ++jj) if (4 * j4 + jj < i) acc -= ac[j4][jj] * dl[4 * j4 + jj];
                asm volatile("" : "+v"(acc) :: "memory"); dl[i] = acc; }
#pragma unroll
            for (int q8 = 0; q8 < 4; ++q8) { u32x4 w; w.x = cvt_pk_bf16(dl[8 * q8], dl[8 * q8 + 1]); w.y = cvt_pk_bf16(dl[8 * q8 + 2], dl[8 * q8 + 3]); w.z = cvt_pk_bf16(dl[8 * q8 + 4], dl[8 * q8 + 5]); w.w = cvt_pk_bf16(dl[8 * q8 + 6], dl[8 * q8 + 7]);
                *(LAS u32x4*)(DT + tid * PT + 8 * q8) = w; } }
        __syncthreads();
        {   const bf16x8 Y = *(const LAS bf16x8*)(DT + (16 * wv + fr) * PT + 8 * fq);
#pragma unroll
            for (int mi = 0; mi < 2; ++mi) { const bf16x8 X = *(const LAS bf16x8*)(Pb + (16 * mi + fr) * PT + 8 * fq); accO[mi] = MFMA16(X, Y, accO[mi]);
#pragma unroll
                for (int r = 0; r < 4; ++r) Of[(16 * mi + 4 * fq + r) * 128 + 16 * wv + fr] = accO[mi][r]; }
            const float aL = gbk[31 * 4 + 3];
#pragma unroll
            for (int dm = 0; dm < 8; ++dm) { const bf16x8 X = *(const LAS bf16x8*)(KdT + (16 * dm + fr) * PT + 8 * fq); Sacc[dm] = MFMA16(X, Y, Sacc[dm] * aL); }
        }
        __syncthreads();
        {   f32x2 o[4]; float ss[4];
#pragma unroll
            for (int u = 0; u < 4; ++u) { o[u] = *(const LAS f32x2*)(Of + (wv + 8 * u) * 128 + lane * 2); ss[u] = o[u].x * o[u].x + o[u].y * o[u].y; }
#pragma unroll
            for (int u = 0; u < 4; ++u) ss[u] = wave_sum(ss[u]);
#pragma unroll
            for (int u = 0; u < 4; ++u) { const int tok = wv + 8 * u;
                if (tok < nb) { const float r = __builtin_amdgcn_rsqf(ss[u] * (1.0f / 128.f) + EPS); const unsigned zz = *(const LAS unsigned*)(zr + tok * 128 + lane * 2);
                    *(unsigned*)(OG + (size_t)(row0 + t0 + tok) * VAL_DIM + hv * 128 + lane * 2) = cvt_pk_bf16(o[u].x * r * nw.x * silu_f(bflo(zz)), o[u].y * r * nw.y * silu_f(bfhi(zz))); } }
        }
        __syncthreads();
    }
    {   const int lane = tid0 & 63, wv = tid0 >> 6, fr = lane & 15, fq = lane >> 4;
        float* sd = (isPrompt ? P.out + O_DELTAP + ((size_t)(j * NB + b) * HV + hv) * 16384 : P.out + O_DELTAS + ((size_t)(j * DB + b) * HV + hv) * 16384) + 16 * wv + fr;
#pragma unroll
        for (int dm = 0; dm < 8; ++dm)
#pragma unroll
            for (int r = 0; r < 4; ++r) sd[(16 * dm + 4 * fq + r) * 128] = Sacc[dm][r]; }
}
__device__ __forceinline__ void delta_phase(LAS unsigned char* L, const Params& P, int j) {
    const int G = gridDim.x, bid = blockIdx.x;
    const bf16_t* proj = (const bf16_t*)(P.ws + WS_PROJ);
    {
        const size_t gtid = (size_t)bid * NTHREADS + opaque_tid(), gsz = (size_t)G * NTHREADS;
        for (size_t it = gtid; it < (size_t)NB * 3 * CONV_DIM; it += gsz) { const int b = (int)(it / (3 * CONV_DIM)), r = (int)(it % (3 * CONV_DIM)), p = r / CONV_DIM, c = r % CONV_DIM;
            P.out[O_CONVP + (size_t)j * NB * 3 * CONV_DIM + it] = bf2f(proj[(size_t)(b * SEQ + SEQ - 3 + p) * IN_PAD + c]); }
        for (size_t it = gtid; it < (size_t)DB * 3 * CONV_DIM; it += gsz) { const int b = (int)(it / (3 * CONV_DIM)), r = (int)(it % (3 * CONV_DIM)), p = r / CONV_DIM, c = r % CONV_DIM;
            P.out[O_CONVS + (size_t)j * DB * 3 * CONV_DIM + it] = bf2f(proj[(size_t)(TP + b * DS + 1 + p) * IN_PAD + c]); }
    }
    const int nP = NB * HV, nS = DB * HV;
#pragma unroll 1
    for (int k = 0;; ++k) {
        int it;
        if (G >= 2 * nP) { if (bid < nP) { if (k > 0) break; it = bid; } else it = nP + (bid - nP) + k * (G - nP); }
        else it = bid + k * G;
        if (it >= nP + nS) break;
        const bool isPrompt = it < nP; const int ii = isPrompt ? it : it - nP;
        delta_item(L, P, j, isPrompt, ii / HV, ii % HV);
    }
}

#define XB_TMO      128
#define XB_XCNT(j)  (256  + 64 * (j))
#define XB_XSUB(j)  (1280 + 64 * (j))
#define XB_XGEN(j)  (2304 + 64 * (j))
#define XB_TOP      3328
#define XB_TOPGEN   3392
#define XCD_BAR_WORDS 3456
#define XB_SPIN_CAP (1u << 22)
constexpr int LDS_ST_OFF = LDS_BYTES - 64;
__device__ __forceinline__ unsigned xb_ld(unsigned* p)              { return __hip_atomic_load(p, __ATOMIC_RELAXED, __HIP_MEMORY_SCOPE_AGENT); }
__device__ __forceinline__ unsigned xb_add(unsigned* p, unsigned v) { return __hip_atomic_fetch_add(p, v, __ATOMIC_RELAXED, __HIP_MEMORY_SCOPE_AGENT); }
__device__ __forceinline__ unsigned xb_xcc_id() { return (unsigned)__builtin_amdgcn_s_getreg((3 << 11) | 20) & 0xFu; }
#define XB_SPIN(cond, bar) do { unsigned _sp = 0; while (cond) { __builtin_amdgcn_s_sleep(1); \
    if ((++_sp & 255u) == 0u) { if (xb_ld(&(bar)[XB_TMO])) break; if (_sp > XB_SPIN_CAP) { atomicAdd(&(bar)[XB_TMO], 1u); break; } } } } while (0)
__device__ __forceinline__ void xcd_barrier_complete(unsigned* bar, unsigned x, unsigned& nloc, unsigned& nx) {
    const unsigned G = gridDim.x;
    unsigned sum, cnt, mine, sp = 0u;
    for (;;) {
        sum = 0u; cnt = 0u; mine = 0u;
#pragma unroll
        for (unsigned j = 0; j < 16; ++j) { const unsigned c = xb_ld(&bar[XB_XCNT(j)]); sum += c; cnt += (c > 0u) ? 1u : 0u; mine = (j == x) ? c : mine; }
        if (sum == G) break;
        __builtin_amdgcn_s_sleep(1);
        if ((++sp & 255u) == 0u) { if (xb_ld(&bar[XB_TMO])) break; if (sp > XB_SPIN_CAP) { atomicAdd(&bar[XB_TMO], 1u); break; } }
    }
    nloc = mine > 0u ? mine : 1u; nx = cnt > 0u ? cnt : 1u;
}
__device__ __forceinline__ void xcd_barrier(unsigned* bar, volatile LAS unsigned* st) {
    asm volatile("s_waitcnt vmcnt(0)" ::: "memory");
    __syncthreads();
    if (threadIdx.x == 0) {
        const unsigned x = xb_xcc_id();
        __builtin_amdgcn_s_waitcnt(0);
        unsigned nloc = st[0], nx = st[1];
        if (nloc == 0u) { xcd_barrier_complete(bar, x, nloc, nx); st[0] = nloc; st[1] = nx; }
        const unsigned old = xb_add(&bar[XB_XSUB(x)], 1u);
        const unsigned gen = old / nloc;
        if (old + 1u == (gen + 1u) * nloc) {
            __builtin_amdgcn_fence(__ATOMIC_RELEASE, "agent");
            asm volatile("s_waitcnt vmcnt(0)" ::: "memory");
            const unsigned og = xb_add(&bar[XB_TOP], 1u);
            const unsigned tg = og / nx;
            if (og + 1u == (tg + 1u) * nx) xb_add(&bar[XB_TOPGEN], 1u);
            else XB_SPIN(xb_ld(&bar[XB_TOPGEN]) == tg, bar);
            __builtin_amdgcn_fence(__ATOMIC_ACQUIRE, "agent");
            xb_add(&bar[XB_XGEN(x)], 1u);
            asm volatile("s_waitcnt vmcnt(0)" ::: "memory");
        } else {
            XB_SPIN(xb_ld(&bar[XB_XGEN(x)]) == gen, bar);
            __builtin_amdgcn_fence(__ATOMIC_ACQUIRE, "agent");
            asm volatile("s_waitcnt vmcnt(0)" ::: "memory");
        }
    }
    __syncthreads();
}

typedef const __attribute__((address_space(4))) Params* KP;
__device__ __forceinline__ Params ldp(KP kp) {
    asm volatile("" : "+s"(kp));
    Params P;
    P.x_prompt = kp->x_prompt; P.x_sample = kp->x_sample; P.state_pool = kp->state_pool; P.state_conv = kp->state_conv; P.state_delta = kp->state_delta; P.norm_gains = kp->norm_gains;
    P.w_gate = kp->w_gate; P.w_up = kp->w_up; P.w_down = kp->w_down; P.pool_w = kp->pool_w; P.pool_scale = kp->pool_scale; P.dn_w_in = kp->dn_w_in; P.dn_conv_w = kp->dn_conv_w;
    P.dn_a_log = kp->dn_a_log; P.dn_dt_bias = kp->dn_dt_bias; P.dn_norm_w = kp->dn_norm_w; P.dn_w_out = kp->dn_w_out; P.out = kp->out; P.ws = kp->ws;
    return P;
}
__global__ void __launch_bounds__(NTHREADS, 2) mk_fwd(Params Punused) {
    extern __shared__ __attribute__((aligned(16))) unsigned char lds_raw[];
    LAS unsigned char* lds = (LAS unsigned char*)lds_raw;
    cg::grid_group grid = cg::this_grid();
    KP kp = (KP)__builtin_amdgcn_kernarg_segment_ptr();

    {   const Params P = ldp(kp); unsigned* bar = (unsigned*)(P.ws + WS_BAR);
        if (blockIdx.x == 0) for (int i = threadIdx.x; i < XCD_BAR_WORDS; i += NTHREADS) bar[i] = 0u;
        if (threadIdx.x == 0) { ((volatile LAS unsigned*)(lds + LDS_ST_OFF))[0] = 0u; ((volatile LAS unsigned*)(lds + LDS_ST_OFF))[1] = 0u; } }
    { const Params P = ldp(kp); convert_weights((LAS float*)lds, P); }
    { const Params P = ldp(kp); row_pass(P, 0, 0.f, nullptr, P.norm_gains, -1); }
    grid.sync();
    if (threadIdx.x == 0) { const Params P = ldp(kp); (void)xb_add(&((unsigned*)(P.ws + WS_BAR))[XB_XCNT(xb_xcc_id())], 1u); }
#define GBAR() do { const Params Pb = ldp(kp); xcd_barrier((unsigned*)(Pb.ws + WS_BAR), (volatile LAS unsigned*)(lds + LDS_ST_OFF)); } while (0)

#pragma unroll 1
    for (int step = 0; step < 12; ++step) {
        const int layer = step / 3, sub = step % 3, jm = layer >> 1;
        if (sub != 1) {
            const Params P = ldp(kp); const int l = layer * 2 + (sub >> 1);
            pg8::Gemm g{(const bf16_t*)(P.ws + WS_HN), (const bf16_t*)(P.ws + WS_WGU + l * SZ_WGU), D, D, D, 0}; pg8::StaticOrder S; S.init(T, 2 * FF, gridDim.x, blockIdx.x);
            pg8::EpiSwiGLU E{(bf16_t*)(P.ws + WS_H), FF}; pg8::gemm_phase(lds, g, S, E);
        } else if ((layer & 1) == 0) {
            const Params P = ldp(kp); pool_pass(P, jm);
        } else {
            {   const Params P = ldp(kp);
                pg8::Gemm g{(const bf16_t*)(P.ws + WS_HN), (const bf16_t*)(P.ws + WS_WIN + jm * SZ_WIN), D, D, D, 0}; pg8::StaticOrder S; S.init(T, IN_PAD, gridDim.x, blockIdx.x);
                pg8::EpiBf16 E{(bf16_t*)(P.ws + WS_PROJ), IN_PAD}; pg8::gemm_phase(lds, g, S, E); }
            GBAR();
            { const Params P = ldp(kp); delta_phase(lds, P, jm); }
        }
        GBAR();
        {   const Params P = ldp(kp);
            pg8::Gemm gf; const float* fscale = nullptr; const bf16_t* A = (const bf16_t*)(P.ws + WS_H);
            if (sub != 1) { const int l = layer * 2 + (sub >> 1); gf = pg8::Gemm{A, (const bf16_t*)(P.ws + WS_WDN + l * SZ_WDN), FF, FF, FF, 0}; }
            else if ((layer & 1) == 0) { gf = pg8::Gemm{A, (const bf16_t*)(P.ws + WS_WPOOL + jm * SZ_WPOOL), 256, D, 256, 256}; fscale = P.pool_scale + jm * D; }
            else gf = pg8::Gemm{A, (const bf16_t*)(P.ws + WS_WOUT + jm * SZ_WOUT), VAL_DIM, VAL_DIM, VAL_DIM, 0};
            pg8::StaticOrder S; S.init(T, D, gridDim.x, blockIdx.x); pg8::EpiF32 E{(float*)(P.ws + WS_Y), D, fscale}; pg8::gemm_phase(lds, gf, S, E); }
        GBAR();
        {   const Params P = ldp(kp); const float* ng = P.norm_gains + (size_t)layer * 6 * D;
            const float* gpost = ng + (sub == 0 ? 1 : sub == 1 ? 3 : 5) * D;
            const float* gnext = sub == 0 ? ng + 2 * D : sub == 1 ? ng + 4 * D : (layer < 3 ? ng + 6 * D : nullptr);
            row_pass(P, 1, sub == 1 ? 1.0f : 0.5f, gpost, gnext, (sub == 0 && (layer & 1) == 0) ? jm : -1); }
        if (step < 11) GBAR();
    }
}

extern "C" void kernel_launch(void* const* d_in, const int* in_sizes, int n_in, void* d_out, int out_size, void* d_ws, size_t ws_size, hipStream_t stream) {
    static int grid = 0;
    if (grid == 0) {
        int dev = 0, cus = 0, per_cu = 0;
        if (ws_size < WS_END || n_in != 17) { fprintf(stderr, "kernel_launch: need %zu bytes of workspace (got %zu), 17 inputs (got %d)\n", (size_t)WS_END, ws_size, n_in); grid = -1; return; }
        if (hipGetDevice(&dev) != hipSuccess || hipDeviceGetAttribute(&cus, hipDeviceAttributeMultiprocessorCount, dev) != hipSuccess) { grid = -1; return; }
        if (hipFuncSetAttribute((const void*)mk_fwd, hipFuncAttributeMaxDynamicSharedMemorySize, LDS_BYTES) != hipSuccess) { fprintf(stderr, "hipFuncSetAttribute failed\n"); grid = -1; return; }
        if (hipOccupancyMaxActiveBlocksPerMultiprocessor(&per_cu, (const void*)mk_fwd, NTHREADS, LDS_BYTES) != hipSuccess || per_cu < 1) { fprintf(stderr, "occupancy query: %d\n", per_cu); }
        (void)hipGetLastError();
        grid = cus;
    }
    if (grid < 0) return;
    Params p{};
    p.x_prompt = (const float*)d_in[0]; p.x_sample = (const float*)d_in[1]; p.state_pool = (const float*)d_in[2]; p.state_conv = (const float*)d_in[3]; p.state_delta = (const float*)d_in[4];
    p.norm_gains = (const float*)d_in[5]; p.w_gate = (const float*)d_in[6]; p.w_up = (const float*)d_in[7]; p.w_down = (const float*)d_in[8]; p.pool_w = (const float*)d_in[9];
    p.pool_scale = (const float*)d_in[10]; p.dn_w_in = (const float*)d_in[11]; p.dn_conv_w = (const float*)d_in[12]; p.dn_a_log = (const float*)d_in[13]; p.dn_dt_bias = (const float*)d_in[14];
    p.dn_norm_w = (const float*)d_in[15]; p.dn_w_out = (const float*)d_in[16];
    p.out = (float*)d_out; p.ws = (unsigned char*)d_ws;
    void* args[] = {&p};
    hipError_t e = hipLaunchCooperativeKernel((const void*)mk_fwd, dim3(grid), dim3(NTHREADS), args, LDS_BYTES, stream);
    if (e != hipSuccess) fprintf(stderr, "cooperative launch failed: %s (grid %d)\n", hipGetErrorString(e), grid);
}
```

```cpp
#include <hip/hip_runtime.h>
#include <hip/hip_cooperative_groups.h>
#include <cstdio>
namespace cg = cooperative_groups;

#define LAS __attribute__((address_space(3)))
typedef unsigned short bf16_t;
typedef short bf16x8 __attribute__((ext_vector_type(8)));
typedef float f32x4 __attribute__((ext_vector_type(4)));
typedef float f32x2 __attribute__((ext_vector_type(2)));
typedef unsigned u32x4 __attribute__((ext_vector_type(4)));
typedef unsigned u32x2 __attribute__((ext_vector_type(2)));

constexpr int D = 1024, FF = 2816, SEQ = 2048, NB = 8, DB = 128, DS = 4;
constexpr int TP = NB * SEQ, TS = DB * DS, T = TP + TS;
constexpr int CONV_DIM = 4096, IN_DIM = 6176, IN_PAD = 6400, VAL_DIM = 2048, HV = 16;
constexpr float EPS = 1e-6f;
constexpr int NTHREADS = 512;
constexpr int LDS_BYTES = 144 * 1024;

constexpr size_t SZ_WGU = (size_t)2 * FF * D * 2, SZ_WDN = (size_t)D * FF * 2, SZ_WIN = (size_t)IN_PAD * D * 2, SZ_WOUT = (size_t)D * VAL_DIM * 2, SZ_WPOOL = (size_t)D * 256 * 2;
constexpr size_t WS_WGU = 0;
constexpr size_t WS_WDN = WS_WGU + 8 * SZ_WGU;
constexpr size_t WS_WIN = WS_WDN + 8 * SZ_WDN;
constexpr size_t WS_WOUT = WS_WIN + 2 * SZ_WIN;
constexpr size_t WS_WPOOL = WS_WOUT + 2 * SZ_WOUT;
constexpr size_t WS_HN = WS_WPOOL + 2 * SZ_WPOOL;
constexpr size_t WS_H = WS_HN + (size_t)T * D * 2;
constexpr size_t WS_Y = WS_H + (size_t)T * FF * 2;
constexpr size_t WS_PROJ = WS_Y + (size_t)T * D * 4;
constexpr size_t WS_YP = WS_PROJ + (size_t)T * IN_PAD * 2;
constexpr size_t WS_BAR = WS_YP + (size_t)11 * TS * D * 4;
constexpr size_t WS_END = WS_BAR + 16384;

constexpr size_t O_Y = 0;
constexpr size_t O_POOLP = (size_t)T * D;
constexpr size_t O_CONVP = O_POOLP + (size_t)2 * NB * 15 * D;
constexpr size_t O_DELTAP = O_CONVP + (size_t)2 * NB * 3 * CONV_DIM;
constexpr size_t O_POOLS = O_DELTAP + (size_t)2 * NB * HV * 16384;
constexpr size_t O_CONVS = O_POOLS + (size_t)2 * DB * 15 * D;
constexpr size_t O_DELTAS = O_CONVS + (size_t)2 * DB * 3 * CONV_DIM;

struct Params {
    const float* x_prompt; const float* x_sample; const float* state_pool; const float* state_conv; const float* state_delta; const float* norm_gains;
    const float* w_gate; const float* w_up; const float* w_down; const float* pool_w; const float* pool_scale; const float* dn_w_in; const float* dn_conv_w;
    const float* dn_a_log; const float* dn_dt_bias; const float* dn_norm_w; const float* dn_w_out;
    float* out; unsigned char* ws;
};

__device__ __forceinline__ unsigned cvt_pk_bf16(float lo, float hi) { unsigned r; asm volatile("v_cvt_pk_bf16_f32 %0, %1, %2" : "=v"(r) : "v"(lo), "v"(hi)); return r; }
__device__ __forceinline__ float bf2f(bf16_t b) { return __uint_as_float(((unsigned)b) << 16); }
__device__ __forceinline__ float bflo(unsigned w) { return __uint_as_float(w << 16); }
__device__ __forceinline__ float bfhi(unsigned w) { return __uint_as_float(w & 0xffff0000u); }
__device__ __forceinline__ float silu_f(float x) { return x * __builtin_amdgcn_rcpf(1.0f + __builtin_amdgcn_exp2f(-1.44269504089f * x)); }
__device__ __forceinline__ int opaque_tid() { int t = threadIdx.x; asm volatile("" : "+v"(t)); return t; }
template <int CTRL> __device__ __forceinline__ float dppf(float x) { return __builtin_bit_cast(float, __builtin_amdgcn_mov_dpp(__builtin_bit_cast(int, x), CTRL, 0xf, 0xf, true)); }
__device__ __forceinline__ float red8(float x) { x += dppf<0xB1>(x); x += dppf<0x4E>(x); x += dppf<0x141>(x); return x; }
__device__ __forceinline__ float rl(float x, int l) { return __builtin_bit_cast(float, __builtin_amdgcn_readlane(__builtin_bit_cast(int, x), l)); }
__device__ __forceinline__ float wave_sum(float x) {
    x = red8(x); x += dppf<0x140>(x);
    return (rl(x, 0) + rl(x, 16)) + (rl(x, 32) + rl(x, 48));
}

namespace pg8 {
constexpr int BM = 256, BK = 64, HALF = 128, HTB = HALF * BK * 2, STAGE_BYTES = 8 * HTB, NXCD = 8, WGM = 8;
__device__ __forceinline__ int lds_byte(int r, int c) { const int st = (r >> 4) * 2 + (c >> 5), rr = r & 15, cc = c & 31, ob = rr * 64 + cc * 2; return st * 1024 + (ob ^ (((ob >> 9) & 1) << 5)); }
__device__ __forceinline__ void stage_rc(int b, int& R, int& C) { const int st = b / 1024, sb = b % 1024, swz = sb ^ (((sb >> 9) & 1) << 5); R = (st >> 1) * 16 + swz / 64; C = (st & 1) * 32 + (swz % 64) / 2; }
__device__ __forceinline__ int perm32(int rho) { const int n = rho >> 4, i = rho & 15; return 8 * (i >> 2) + 4 * n + (i & 3); }

struct Unit { int pm, pn, k0, nt; };
struct Gemm { const bf16_t* A; const bf16_t* Bt; int K, lda, ldb, acol; };

struct StaticOrder {
    int nM, nN, nwg, G, c, nt0;
    __device__ void init(int M, int N, int K, int G_, int c_) { nM = M / BM; nN = N / BM; nwg = nM * nN; G = G_; c = c_; nt0 = K / BK; }
    __device__ bool next(int i, Unit& u) const {
        const long L = (long)i * G + c; if (L >= nwg) return false;
        int wgid = (int)L; { const int q = nwg / NXCD, r = nwg % NXCD, xcd = wgid % NXCD, off = wgid / NXCD; wgid = (xcd < r ? xcd * (q + 1) : r * (q + 1) + (xcd - r) * q) + off; }
        const int nig = WGM * nN, gid = wgid / nig, fm = gid * WGM, gsz = (nM - fm) < WGM ? (nM - fm) : WGM;
        u.pm = fm + ((wgid % nig) % gsz); u.pn = (wgid % nig) / gsz; u.k0 = 0; u.nt = nt0; return true;
    }
};
struct FinalOrder {
    int G, c, nt0, nsplit;
    __device__ void init(int K, int nsplit_, int G_, int c_) { G = G_; c = c_; nt0 = K / BK; nsplit = nsplit_; }
    __device__ __forceinline__ bool next(int i, Unit& u) const {
        const long L = (long)i * G + c; if (L >= 256 + 8 * nsplit) return false;
        const bool big = L < 256; const int Li = (int)L;
        const int wgid = (Li % NXCD) * 32 + ((Li / NXCD) & 31), nig = WGM * 4;
        const int s = Li - 256, u8 = s / nsplit, ks = s - u8 * nsplit, nts = nt0 / nsplit;
        const int pm = big ? (wgid / nig) * WGM + ((wgid % nig) % WGM) : 64 + (u8 >> 2), pn = big ? (wgid % nig) / WGM : (u8 & 3), k0 = big ? 0 : ks * nts * BK, nt = big ? nt0 : nts;
        u.pm = pm; u.pn = pn; u.k0 = k0; u.nt = nt; return true;
    }
};

struct EpiF32 {
    static constexpr bool PERM = false;
    static constexpr int ldc = D; float* C; const float* scale;
    __device__ __forceinline__ void operator()(const f32x4 (&acc)[2][2][4][2], const Unit& u, int wr, int wc, int fr, int fq) const {
        const int row0 = u.pm * BM + wr * 64 + fr, col0 = u.pn * BM + wc * 32 + 4 * fq;
        f32x4 sv[2][2];
#pragma unroll
        for (int bj = 0; bj < 2; ++bj)
#pragma unroll
            for (int n = 0; n < 2; ++n) sv[bj][n] = scale ? *(const f32x4*)(scale + col0 + bj * HALF + n * 16) : (f32x4){1.f, 1.f, 1.f, 1.f};
#pragma unroll
        for (int ai = 0; ai < 2; ++ai)
#pragma unroll
            for (int m = 0; m < 4; ++m) { float* rowp = (u.pm < 64 ? C : C + (WS_YP - WS_Y) / 4 + (size_t)(u.k0 >> 8) * 512 * ldc - (size_t)64 * BM * ldc) + (size_t)(row0 + ai * HALF + m * 16) * ldc + col0;
#pragma unroll
                for (int bj = 0; bj < 2; ++bj)
#pragma unroll
                    for (int n = 0; n < 2; ++n) *(f32x4*)(rowp + bj * HALF + n * 16) = acc[ai][bj][m][n] * sv[bj][n]; }
    }
};
struct EpiBf16 {
    static constexpr bool PERM = true;
    bf16_t* O; int ldc;
    __device__ __forceinline__ void operator()(const f32x4 (&acc)[2][2][4][2], const Unit& u, int wr, int wc, int fr, int fq) const {
        const int row0 = u.pm * BM + wr * 64 + fr, col0 = u.pn * BM + wc * 32 + 8 * fq;
#pragma unroll
        for (int ai = 0; ai < 2; ++ai)
#pragma unroll
            for (int m = 0; m < 4; ++m) { bf16_t* rowp = O + (size_t)(row0 + ai * HALF + m * 16) * ldc + col0;
#pragma unroll
                for (int bj = 0; bj < 2; ++bj) { const f32x4 v0 = acc[ai][bj][m][0], v1 = acc[ai][bj][m][1];
                    u32x4 w; w.x = cvt_pk_bf16(v0[0], v0[1]); w.y = cvt_pk_bf16(v0[2], v0[3]); w.z = cvt_pk_bf16(v1[0], v1[1]); w.w = cvt_pk_bf16(v1[2], v1[3]);
                    *(u32x4*)(rowp + bj * HALF) = w; } }
    }
};
struct EpiSwiGLU {
    static constexpr bool PERM = true;
    bf16_t* O; int ldc;
    __device__ __forceinline__ void operator()(const f32x4 (&acc)[2][2][4][2], const Unit& u, int wr, int wc, int fr, int fq) const {
        const int row0 = u.pm * BM + wr * 64 + fr, col0 = u.pn * HALF + wc * 32 + 8 * fq;
#pragma unroll
        for (int ai = 0; ai < 2; ++ai)
#pragma unroll
            for (int m = 0; m < 4; ++m) { bf16_t* rowp = O + (size_t)(row0 + ai * HALF + m * 16) * ldc + col0;
                const f32x4 g0 = acc[ai][0][m][0], g1 = acc[ai][0][m][1], u0 = acc[ai][1][m][0], u1 = acc[ai][1][m][1];
                u32x4 w; w.x = cvt_pk_bf16(silu_f(g0[0]) * u0[0], silu_f(g0[1]) * u0[1]); w.y = cvt_pk_bf16(silu_f(g0[2]) * u0[2], silu_f(g0[3]) * u0[3]);
                w.z = cvt_pk_bf16(silu_f(g1[0]) * u1[0], silu_f(g1[1]) * u1[1]); w.w = cvt_pk_bf16(silu_f(g1[2]) * u1[2], silu_f(g1[3]) * u1[3]);
                *(u32x4*)rowp = w; }
    }
};

template <class Epi, class Sched>
__device__ __forceinline__ void gemm_phase(LAS unsigned char* lds, const Gemm g, const Sched& S, const Epi& E) {
    const int tid = opaque_tid(), wid = __builtin_amdgcn_readfirstlane(tid >> 6), lane = tid & 63, wr = wid >> 2, wc = wid & 3, fr = lane & 15, fq = lane >> 4;
    unsigned voffA[2], voffB[2];
#pragma unroll
    for (int i = 0; i < 2; ++i) { int R, C; stage_rc(tid * 16 + i * 8192, R, C); const int Rb = Epi::PERM ? ((R & ~31) + perm32(R & 31)) : R;
        voffA[i] = (unsigned)(R * g.lda + C) * 2u; voffB[i] = (unsigned)(Rb * g.ldb + C) * 2u; }
    const size_t kstep = (size_t)(BK * 2);
    const size_t hstepA = (size_t)HALF * g.lda * 2, hstepB = (size_t)HALF * g.ldb * 2;
    const size_t tstepA = 2 * hstepA, tstepB = 2 * hstepB;
    const unsigned ldsw = (unsigned)wid * 1024u;
    const int aoff = lds_byte(wr * 64 + fr, fq * 8), boff = lds_byte(wc * 32 + fr, fq * 8);
#define PG8_SA(b, h) (((b) * 2 + (h)) * HTB)
#define PG8_SB(b, h) ((4 + (b) * 2 + (h)) * HTB)
#define PG8_STAGE(bufoff, gbase, voff) do { _Pragma("unroll") for (int _i = 0; _i < 2; ++_i) \
        __builtin_amdgcn_global_load_lds((const unsigned*)((const char*)(gbase) + (voff)[_i]), (LAS unsigned*)(lds + (bufoff) + ldsw + _i * 8192), 16, 0, 0); } while (0)
#define PG8_LDA(dst, b, h) do { _Pragma("unroll") for (int m = 0; m < 4; ++m) _Pragma("unroll") for (int k = 0; k < 2; ++k) dst[m][k] = *(const LAS bf16x8*)(lds + PG8_SA(b, h) + aoff + m * 2048 + k * 1024); } while (0)
#define PG8_LDB(dst, b, h) do { _Pragma("unroll") for (int n = 0; n < 2; ++n) _Pragma("unroll") for (int k = 0; k < 2; ++k) dst[n][k] = *(const LAS bf16x8*)(lds + PG8_SB(b, h) + boff + n * 2048 + k * 1024); } while (0)
#define PG8_MMA(ai, bj, At, Bt) do { __builtin_amdgcn_s_setprio(1); _Pragma("unroll") for (int m = 0; m < 4; ++m) _Pragma("unroll") for (int n = 0; n < 2; ++n) _Pragma("unroll") for (int k = 0; k < 2; ++k) \
        acc[ai][bj][m][n] = __builtin_amdgcn_mfma_f32_16x16x32_bf16(Bt[n][k], At[m][k], acc[ai][bj][m][n], 0, 0, 0); __builtin_amdgcn_s_setprio(0); } while (0)
#define PG8_WAIT_V(n) asm volatile("s_waitcnt vmcnt(" #n ")" ::: "memory")
#define PG8_WAIT_L(n) asm volatile("s_waitcnt lgkmcnt(" #n ")" ::: "memory")
#define PG8_BAR __builtin_amdgcn_s_barrier()
#define PG8_SCHED __builtin_amdgcn_sched_barrier(0)
    Unit cur, nxt; int ui = 0;
    if (!S.next(0, cur)) return;
    f32x4 acc[2][2][4][2];
#pragma unroll
    for (int a = 0; a < 2; ++a)
#pragma unroll
        for (int b = 0; b < 2; ++b)
#pragma unroll
            for (int m = 0; m < 4; ++m)
#pragma unroll
                for (int n = 0; n < 2; ++n) acc[a][b][m][n] = (f32x4){0.f, 0.f, 0.f, 0.f};
    bf16x8 At[4][2], B0[2][2], B1[2][2];
    const char* cA = (const char*)g.A + (size_t)cur.pm * tstepA + (size_t)(cur.pn * g.acol + cur.k0) * 2; const char* cB = (const char*)g.Bt + (size_t)cur.pn * tstepB + (size_t)cur.k0 * 2;
    PG8_STAGE(PG8_SB(0, 0), cB, voffB); PG8_STAGE(PG8_SA(0, 0), cA, voffA); PG8_STAGE(PG8_SB(0, 1), cB + hstepB, voffB); PG8_STAGE(PG8_SA(0, 1), cA + hstepA, voffA);
    if (wr == 1) PG8_BAR;
    PG8_WAIT_V(4); PG8_BAR;
    PG8_STAGE(PG8_SB(1, 0), cB + kstep, voffB); PG8_STAGE(PG8_SA(1, 0), cA + kstep, voffA); PG8_STAGE(PG8_SB(1, 1), cB + hstepB + kstep, voffB);
    PG8_WAIT_V(6); PG8_BAR;
    for (;;) {
        const bool has_next = S.next(ui + 1, nxt);
        const char* nA = has_next ? (const char*)g.A + (size_t)nxt.pm * tstepA + (size_t)(nxt.pn * g.acol + nxt.k0) * 2 : cA; const char* nB = has_next ? (const char*)g.Bt + (size_t)nxt.pn * tstepB + (size_t)nxt.k0 * 2 : cB;
        const int nt = cur.nt;
        for (int t = 0; t < nt; t += 2) {
            const bool last = (t == nt - 2);
            const char* a1 = cA + (size_t)(t + 1) * kstep;
            const char* a2 = last ? nA : cA + (size_t)(t + 2) * kstep; const char* b2 = last ? nB : cB + (size_t)(t + 2) * kstep;
            const char* a3 = a2 + kstep; const char* b3 = b2 + kstep;
            PG8_LDB(B0, 0, 0); PG8_SCHED; PG8_LDA(At, 0, 0); PG8_STAGE(PG8_SA(1, 1), a1 + hstepA, voffA);
            PG8_WAIT_L(8); PG8_BAR; PG8_WAIT_L(0); PG8_MMA(0, 0, At, B0); PG8_BAR; PG8_SCHED;
            PG8_LDB(B1, 0, 1); PG8_STAGE(PG8_SB(0, 0), b2, voffB);
            PG8_BAR; PG8_WAIT_L(0); PG8_MMA(0, 1, At, B1); PG8_BAR;
            PG8_LDA(At, 0, 1); PG8_STAGE(PG8_SA(0, 0), a2, voffA);
            PG8_BAR; PG8_WAIT_L(0); PG8_MMA(1, 0, At, B0); PG8_BAR; PG8_SCHED;
            PG8_STAGE(PG8_SB(0, 1), b2 + hstepB, voffB);
            PG8_WAIT_V(6); PG8_BAR; PG8_MMA(1, 1, At, B1); PG8_BAR;
            PG8_LDB(B0, 1, 0); PG8_SCHED; PG8_LDA(At, 1, 0); PG8_STAGE(PG8_SA(0, 1), a2 + hstepA, voffA);
            PG8_WAIT_L(8); PG8_BAR; PG8_WAIT_L(0); PG8_MMA(0, 0, At, B0); PG8_BAR; PG8_SCHED;
            PG8_LDB(B1, 1, 1); PG8_STAGE(PG8_SB(1, 0), b3, voffB);
            PG8_BAR; PG8_WAIT_L(0); PG8_MMA(0, 1, At, B1); PG8_BAR;
            PG8_LDA(At, 1, 1); PG8_STAGE(PG8_SA(1, 0), a3, voffA);
            PG8_BAR; PG8_WAIT_L(0); PG8_MMA(1, 0, At, B0); PG8_BAR; PG8_SCHED;
            PG8_STAGE(PG8_SB(1, 1), b3 + hstepB, voffB);
            PG8_WAIT_V(6); PG8_BAR; PG8_MMA(1, 1, At, B1); PG8_BAR;
        }
        E(acc, cur, wr, wc, fr, fq);
        if (!has_next) break;
#pragma unroll
        for (int a = 0; a < 2; ++a)
#pragma unroll
            for (int b = 0; b < 2; ++b)
#pragma unroll
                for (int m = 0; m < 4; ++m)
#pragma unroll
                    for (int n = 0; n < 2; ++n) acc[a][b][m][n] = (f32x4){0.f, 0.f, 0.f, 0.f};
        cur = nxt; cA = nA; cB = nB; ++ui;
    }
    PG8_WAIT_V(0);
    if (wr == 0) PG8_BAR;
    PG8_BAR;
#undef PG8_SA
#undef PG8_SB
#undef PG8_STAGE
#undef PG8_LDA
#undef PG8_LDB
#undef PG8_MMA
#undef PG8_WAIT_V
#undef PG8_WAIT_L
#undef PG8_BAR
#undef PG8_SCHED
}
}

constexpr int CT_GU = 8 * 16 * 88, CT_DN = 8 * 44 * 16, CT_IN = 2 * 16 * 100, CT_OUT = 2 * 32 * 16, CT_POOL = 8 * 4 * 4;
constexpr int CT_TOTAL = CT_GU + CT_DN + CT_IN + CT_OUT + CT_POOL;

__device__ __forceinline__ void convert_weights(LAS float* tile, const Params& P) {
    const int tid = opaque_tid();
    for (int t = blockIdx.x; t < CT_TOTAL; t += gridDim.x) {
        const float* src; int ldsrc, k0, n0, nvalid, lddst, dstrow0; bf16_t* dst;
        if (t < CT_GU) { const int l = t / 1408, rem = t % 1408, kt = rem % 16, rt = rem / 16, r0 = rt * 64, pn = r0 >> 8, bj = (r0 >> 7) & 1, j0 = r0 & 127;
            src = (bj ? P.w_up : P.w_gate) + (size_t)l * D * FF; ldsrc = FF; k0 = kt * 64; n0 = 128 * pn + j0; nvalid = FF; dst = (bf16_t*)(P.ws + WS_WGU + l * SZ_WGU); lddst = D; dstrow0 = r0; }
        else if (t < CT_GU + CT_DN) { const int tt = t - CT_GU, l = tt / 704, rem = tt % 704, kt = rem % 44, nt_ = rem / 44;
            src = P.w_down + (size_t)l * FF * D; ldsrc = D; k0 = kt * 64; n0 = nt_ * 64; nvalid = D; dst = (bf16_t*)(P.ws + WS_WDN + l * SZ_WDN); lddst = FF; dstrow0 = n0; }
        else if (t < CT_GU + CT_DN + CT_IN) { const int tt = t - CT_GU - CT_DN, l = tt / 1600, rem = tt % 1600, kt = rem % 16, nt_ = rem / 16;
            src = P.dn_w_in + (size_t)l * D * IN_DIM; ldsrc = IN_DIM; k0 = kt * 64; n0 = nt_ * 64; nvalid = IN_DIM; dst = (bf16_t*)(P.ws + WS_WIN + l * SZ_WIN); lddst = D; dstrow0 = n0; }
        else if (t < CT_GU + CT_DN + CT_IN + CT_OUT) { const int tt = t - CT_GU - CT_DN - CT_IN, l = tt / 512, rem = tt % 512, kt = rem % 32, nt_ = rem / 32;
            src = P.dn_w_out + (size_t)l * VAL_DIM * D; ldsrc = D; k0 = kt * 64; n0 = nt_ * 64; nvalid = D; dst = (bf16_t*)(P.ws + WS_WOUT + l * SZ_WOUT); lddst = VAL_DIM; dstrow0 = n0; }
        else { const int tt = t - CT_GU - CT_DN - CT_IN - CT_OUT, mtx = tt / 16, rem = tt % 16, kt = rem % 4, nt_ = rem / 4;
            src = P.pool_w + (size_t)mtx * 65536; ldsrc = 256; k0 = kt * 64; n0 = nt_ * 64; nvalid = 256; dst = (bf16_t*)(P.ws + WS_WPOOL) + (size_t)mtx * 65536; lddst = 256; dstrow0 = n0; }
        {   const int rr = tid >> 4, c4 = tid & 15, n = n0 + c4 * 4;
#pragma unroll
            for (int h = 0; h < 2; ++h) { const int k = rr + h * 32;
                f32x4 v = (f32x4){0.f, 0.f, 0.f, 0.f};
                if (n < nvalid) v = *(const f32x4*)(src + (size_t)(k0 + k) * ldsrc + n);
                LAS float* tp = tile + k * 65 + c4 * 4; tp[0] = v[0]; tp[1] = v[1]; tp[2] = v[2]; tp[3] = v[3]; }
        }
        __syncthreads();
        {   const int n = tid >> 3, kg = tid & 7; const LAS float* tp = tile + (kg * 8) * 65 + n;
            u32x4 w; w.x = cvt_pk_bf16(tp[0], tp[65]); w.y = cvt_pk_bf16(tp[130], tp[195]); w.z = cvt_pk_bf16(tp[260], tp[325]); w.w = cvt_pk_bf16(tp[390], tp[455]);
            *(u32x4*)(dst + (size_t)(dstrow0 + n) * lddst + k0 + kg * 8) = w;
        }
        __syncthreads();
    }
}

__device__ __forceinline__ void row_body(const Params& P, int row, int lane, int mode, float coef, const float* gpost, const float* gnext, int pool_j, int nsplit) {
    float* X = P.out + O_Y; const float* Y = (const float*)(P.ws + WS_Y); bf16_t* HN = (bf16_t*)(P.ws + WS_HN);
    f32x4 x[4];
    if (mode == 0) { const float* src = row < TP ? P.x_prompt + (size_t)row * D : P.x_sample + (size_t)(row - TP) * D;
#pragma unroll
        for (int i = 0; i < 4; ++i) x[i] = *(const f32x4*)(src + i * 256 + lane * 4); }
    else { f32x4 y[4]; float ss = 0.f;
#pragma unroll
        for (int i = 0; i < 4; ++i) x[i] = *(const f32x4*)(X + (size_t)row * D + i * 256 + lane * 4);
        if (row < TP) {
#pragma unroll
            for (int i = 0; i < 4; ++i) y[i] = *(const f32x4*)(Y + (size_t)row * D + i * 256 + lane * 4); }
        else {
#pragma unroll
            for (int i = 0; i < 4; ++i) { const float* yp = (const float*)(P.ws + WS_YP) + (size_t)(row - TP) * D + i * 256 + lane * 4; f32x4 part[11];
#pragma unroll
                for (int p = 0; p < 11; ++p) { part[p] = (f32x4){0.f, 0.f, 0.f, 0.f}; if (p < nsplit) part[p] = *(const f32x4*)(yp + (size_t)p * TS * D); }
                y[i] = ((part[0] + part[1]) + (part[2] + part[3])) + ((part[4] + part[5]) + (part[6] + part[7])) + ((part[8] + part[9]) + part[10]); } }
#pragma unroll
        for (int i = 0; i < 4; ++i) ss += y[i][0] * y[i][0] + y[i][1] * y[i][1] + y[i][2] * y[i][2] + y[i][3] * y[i][3];
        ss = wave_sum(ss); const float r = coef * __builtin_amdgcn_rsqf(ss * (1.0f / D) + EPS);
#pragma unroll
        for (int i = 0; i < 4; ++i) { const f32x4 gp = *(const f32x4*)(gpost + i * 256 + lane * 4); x[i] += y[i] * gp * r; } }
#pragma unroll
    for (int i = 0; i < 4; ++i) *(f32x4*)(X + (size_t)row * D + i * 256 + lane * 4) = x[i];
    if (gnext) { float ss = 0.f;
#pragma unroll
        for (int i = 0; i < 4; ++i) ss += x[i][0] * x[i][0] + x[i][1] * x[i][1] + x[i][2] * x[i][2] + x[i][3] * x[i][3];
        ss = wave_sum(ss); const float r = __builtin_amdgcn_rsqf(ss * (1.0f / D) + EPS);
        float* pdst = nullptr;
        if (pool_j >= 0) { if (row < TP) { const int b = row / SEQ, s = row % SEQ; if (s >= SEQ - 15) pdst = P.out + O_POOLP + ((size_t)(pool_j * NB + b) * 15 + (s - (SEQ - 15))) * D; }
                           else { const int b = (row - TP) / DS, s = (row - TP) % DS; pdst = P.out + O_POOLS + ((size_t)(pool_j * DB + b) * 15 + 11 + s) * D; } }
#pragma unroll
        for (int i = 0; i < 4; ++i) { const f32x4 gn = *(const f32x4*)(gnext + i * 256 + lane * 4); const f32x4 h = x[i] * gn * r;
            u32x2 w; w.x = cvt_pk_bf16(h[0], h[1]); w.y = cvt_pk_bf16(h[2], h[3]); *(u32x2*)(HN + (size_t)row * D + i * 256 + lane * 4) = w;
            if (pdst) *(f32x4*)(pdst + i * 256 + lane * 4) = h; } }
}
__device__ __forceinline__ void row_pass(const Params& P, int mode, float coef, const float* gpost, const float* gnext, int pool_j, int nsplit) {
    const int tid = opaque_tid(), lane = tid & 63, wv = tid >> 6, G = gridDim.x;
    for (int row = blockIdx.x * 8 + wv; row < TP; row += G * 8) row_body(P, row, lane, mode, coef, gpost, gnext, pool_j, nsplit);
    for (int s = wv * G + blockIdx.x; s < TS; s += G * 8) row_body(P, TP + s, lane, mode, coef, gpost, gnext, pool_j, nsplit);
}

template <int W> __device__ __forceinline__ void pool_prompt_item(const bf16_t* HN, bf16_t* PO, int row, int col) {
    const int s = row % SEQ; const int n = (s + 1 < W) ? s + 1 : W;
    u32x4 v[W];
#pragma unroll
    for (int i = 0; i < W; ++i) { v[i] = (u32x4){0u, 0u, 0u, 0u}; if (i < n) v[i] = *(const u32x4*)(HN + (size_t)(row - i) * D + col); }
    float a[8];
#pragma unroll
    for (int q = 0; q < 8; ++q) a[q] = 0.f;
#pragma unroll
    for (int i = 0; i < W; ++i) { a[0] += bflo(v[i].x); a[1] += bfhi(v[i].x); a[2] += bflo(v[i].y); a[3] += bfhi(v[i].y); a[4] += bflo(v[i].z); a[5] += bfhi(v[i].z); a[6] += bflo(v[i].w); a[7] += bfhi(v[i].w); }
    const float ic = 1.0f / (float)n; const u32x4 self = v[0];
    u32x4 o; o.x = cvt_pk_bf16(a[0] * ic - bflo(self.x), a[1] * ic - bfhi(self.x)); o.y = cvt_pk_bf16(a[2] * ic - bflo(self.y), a[3] * ic - bfhi(self.y));
    o.z = cvt_pk_bf16(a[4] * ic - bflo(self.z), a[5] * ic - bfhi(self.z)); o.w = cvt_pk_bf16(a[6] * ic - bflo(self.w), a[7] * ic - bfhi(self.w));
    *(u32x4*)(PO + (size_t)row * D + col) = o;
}
__device__ __forceinline__ void pool_pass(const Params& P, int j) {
    const bf16_t* HN = (const bf16_t*)(P.ws + WS_HN); bf16_t* PO = (bf16_t*)(P.ws + WS_H);
    const float* past = P.state_pool + (size_t)j * DB * 15 * D;
    const size_t gtid = (size_t)blockIdx.x * NTHREADS + opaque_tid(), gsz = (size_t)gridDim.x * NTHREADS;
    for (size_t it = gtid; it < (size_t)T * 128; it += gsz) {
        const int c32 = (int)(it & 31), g = (int)((it >> 6) & 3), row = (int)(it >> 8) * 2 + (int)((it >> 5) & 1), col = g * 256 + c32 * 8, w = 2 << g;
        if (row < TP) { if (g == 0) pool_prompt_item<2>(HN, PO, row, col); else if (g == 1) pool_prompt_item<4>(HN, PO, row, col); else if (g == 2) pool_prompt_item<8>(HN, PO, row, col); else pool_prompt_item<16>(HN, PO, row, col); }
        else { const int b = (row - TP) / DS, s = (row - TP) % DS;
            float a[8];
#pragma unroll
            for (int q = 0; q < 8; ++q) a[q] = 0.f;
            const u32x4 self = *(const u32x4*)(HN + (size_t)row * D + col);
            for (int i = 0; i < w; ++i) {
                if (s - i >= 0) { const u32x4 v = *(const u32x4*)(HN + (size_t)(row - i) * D + col);
                    a[0] += bflo(v.x); a[1] += bfhi(v.x); a[2] += bflo(v.y); a[3] += bfhi(v.y); a[4] += bflo(v.z); a[5] += bfhi(v.z); a[6] += bflo(v.w); a[7] += bfhi(v.w); }
                else { const float* pp = past + ((size_t)b * 15 + (15 + s - i)) * D + col; const f32x4 v0 = *(const f32x4*)pp, v1 = *(const f32x4*)(pp + 4);
                    a[0] += v0[0]; a[1] += v0[1]; a[2] += v0[2]; a[3] += v0[3]; a[4] += v1[0]; a[5] += v1[1]; a[6] += v1[2]; a[7] += v1[3]; } }
            const float ic = 1.0f / (float)w;
            u32x4 o; o.x = cvt_pk_bf16(a[0] * ic - bflo(self.x), a[1] * ic - bfhi(self.x)); o.y = cvt_pk_bf16(a[2] * ic - bflo(self.y), a[3] * ic - bfhi(self.y));
            o.z = cvt_pk_bf16(a[4] * ic - bflo(self.z), a[5] * ic - bfhi(self.z)); o.w = cvt_pk_bf16(a[6] * ic - bflo(self.w), a[7] * ic - bfhi(self.w));
            *(u32x4*)(PO + (size_t)row * D + col) = o; }
    }
    float* dst = P.out + O_POOLS + (size_t)j * DB * 15 * D;
    for (size_t it = gtid; it < (size_t)DB * 11 * (D / 4); it += gsz) { const int b = (int)(it / (11 * 256)), r = (int)(it % (11 * 256)), p = r / 256, c4 = r % 256;
        *(f32x4*)(dst + ((size_t)b * 15 + p) * D + c4 * 4) = *(const f32x4*)(past + ((size_t)b * 15 + p + 4) * D + c4 * 4); }
}

constexpr int TB = 32;
constexpr int C_VF = 0, C_QF = 16384, C_KF = 32768, C_KB = 49152, C_QB = 57856, C_S0T = 66560, C_RAW = 101376, C_KDT = 101376, C_DT = 111616, C_PB = 121856, C_AM = 124416,
              C_Z = 128512, C_CW = 136704, C_GBK = 142848, C_BA = 143360;
constexpr int PK = 136, PT = 40;
constexpr int RAW_PIECES = (TB + 3) * 48;
__device__ __forceinline__ int seg_col(int seg, int hk, int hv) { return seg == 0 ? hk * 128 : (seg == 1 ? 1024 + hk * 128 : 2048 + hv * 128); }
__device__ __forceinline__ void delta_fetch(const bf16_t* proj, const float* cpast, bool isPrompt, int row0, int ntok, int t0, int hk, int hv, int tid, u32x4 (&rr)[4], u32x4& rz, unsigned& rba) {
#pragma unroll
    for (int i = 0; i < 4; ++i) { const int p = tid + NTHREADS * i; rr[i] = (u32x4){0u, 0u, 0u, 0u};
        if (p < RAW_PIECES) { const int r = p / 48, q48 = p % 48, seg = q48 >> 4, l16 = q48 & 15, tt = t0 - 3 + r, col = seg_col(seg, hk, hv) + l16 * 8;
            if (tt >= 0) { if (tt < ntok) rr[i] = *(const u32x4*)(proj + (size_t)(row0 + tt) * IN_PAD + col); }
            else if (!isPrompt) { const float* f = cpast + (3 + tt) * CONV_DIM + col; const f32x4 a = *(const f32x4*)f, c = *(const f32x4*)(f + 4);
                rr[i] = (u32x4){cvt_pk_bf16(a[0], a[1]), cvt_pk_bf16(a[2], a[3]), cvt_pk_bf16(c[0], c[1]), cvt_pk_bf16(c[2], c[3])}; } } }
    {   const int r = tid >> 4, l16 = tid & 15, tt = t0 + r; rz = (u32x4){0u, 0u, 0u, 0u};
        if (tt < ntok) rz = *(const u32x4*)(proj + (size_t)(row0 + tt) * IN_PAD + 4096 + hv * 128 + l16 * 8); }
    rba = 0u;
    if (tid < 2 * TB) { const int r = tid >> 1, tt = t0 + r; if (tt < ntok) rba = proj[(size_t)(row0 + tt) * IN_PAD + 6144 + (tid & 1) * 16 + hv]; }
}
#define MFMA16(X, Y, ACC) __builtin_amdgcn_mfma_f32_16x16x32_bf16((X), (Y), (ACC), 0, 0, 0)
__device__ __forceinline__ void delta_item(LAS unsigned char* LB, const Params& P, int j, bool isPrompt, int b, int hv) {
    const int tid0 = opaque_tid(), hk = hv >> 1;
    LAS float* Vf = (LAS float*)(LB + C_VF); LAS float* qf = (LAS float*)(LB + C_QF); LAS float* kf = (LAS float*)(LB + C_KF); LAS float* Rf = qf; LAS float* Of = kf;
    LAS bf16_t* Kb = (LAS bf16_t*)(LB + C_KB); LAS bf16_t* Qb = (LAS bf16_t*)(LB + C_QB); LAS bf16_t* S0T = (LAS bf16_t*)(LB + C_S0T);
    LAS bf16_t* KdT = (LAS bf16_t*)(LB + C_KDT); LAS bf16_t* DT = (LAS bf16_t*)(LB + C_DT); LAS bf16_t* Pb = (LAS bf16_t*)(LB + C_PB); LAS float* Am = (LAS float*)(LB + C_AM);
    LAS float* gbk = (LAS float*)(LB + C_GBK); LAS float* cw = (LAS float*)(LB + C_CW); LAS bf16_t* raw = (LAS bf16_t*)(LB + C_RAW); LAS bf16_t* zr = (LAS bf16_t*)(LB + C_Z); LAS bf16_t* ba = (LAS bf16_t*)(LB + C_BA);
    const bf16_t* proj = (const bf16_t*)(P.ws + WS_PROJ); bf16_t* OG = (bf16_t*)(P.ws + WS_H);
    const float* conv_w = P.dn_conv_w + (size_t)j * 4 * CONV_DIM; const float* normw = P.dn_norm_w + j * 128;
    const float alog = P.dn_a_log[j * HV + hv], dtb = P.dn_dt_bias[j * HV + hv];
    const int row0 = isPrompt ? b * SEQ : TP + b * DS, ntok = isPrompt ? SEQ : DS;
    const float* cpast = P.state_conv + (size_t)(j * DB + b) * 3 * CONV_DIM;
    u32x4 rr[4], rz; unsigned rba;
    delta_fetch(proj, cpast, isPrompt, row0, ntok, 0, hk, hv, tid0, rr, rz, rba);
    for (int idx = tid0; idx < 4 * 384; idx += NTHREADS) { const int jj = idx / 384, ch = idx % 384; cw[idx] = conv_w[jj * CONV_DIM + seg_col(ch >> 7, hk, hv) + (ch & 127)]; }
    f32x4 Sacc[8];
    { const int lane = tid0 & 63, wv = tid0 >> 6, fr = lane & 15, fq = lane >> 4;
    if (isPrompt) {
#pragma unroll
        for (int dm = 0; dm < 8; ++dm) Sacc[dm] = (f32x4){0.f, 0.f, 0.f, 0.f}; }
    else { const float* s0 = P.state_delta + ((size_t)(j * DB + b) * HV + hv) * 16384 + 16 * wv + fr;
#pragma unroll
        for (int dm = 0; dm < 8; ++dm)
#pragma unroll
            for (int r = 0; r < 4; ++r) Sacc[dm][r] = s0[(16 * dm + 4 * fq + r) * 128]; } }
    const f32x2 nw = *(const f32x2*)(normw + (tid0 & 63) * 2);
    const float nalog = -__expf(alog);
    for (int t0 = 0; t0 < ntok; t0 += TB) {
        const int nb = (ntok - t0) < TB ? (ntok - t0) : TB;
        int tid = tid0; asm volatile("" : "+v"(tid));
        const int lane = tid & 63, wv = __builtin_amdgcn_readfirstlane(tid >> 6), fr = lane & 15, fq = lane >> 4;
#pragma unroll
        for (int i = 0; i < 4; ++i) { const int p = tid + NTHREADS * i; if (p < RAW_PIECES) *(LAS u32x4*)(raw + p * 8) = rr[i]; }
        *(LAS u32x4*)(zr + tid * 8) = rz;
        if (tid < 2 * TB) ba[tid] = (bf16_t)rba;
        __syncthreads();
        if (t0 + TB < ntok) delta_fetch(proj, cpast, isPrompt, row0, ntok, t0 + TB, hk, hv, tid, rr, rz, rba);
        {   const int c = tid & 127, tq = tid >> 7;
#pragma unroll
            for (int p = 0; p < 3; ++p) { const LAS bf16_t* rp = raw + (tq * 8) * 384 + p * 128 + c; LAS float* dstp = (p == 0 ? qf : (p == 1 ? kf : Vf)) + (tq * 8) * 128 + c;
                const float w0 = cw[p * 128 + c], w1 = cw[384 + p * 128 + c], w2 = cw[768 + p * 128 + c], w3 = cw[1152 + p * 128 + c];
                float r0 = bf2f(rp[0]), r1 = bf2f(rp[384]), r2 = bf2f(rp[768]);
#pragma unroll
                for (int t = 0; t < 8; ++t) { const float r3 = bf2f(rp[(t + 3) * 384]); const float acc = r0 * w0 + r1 * w1 + r2 * w2 + r3 * w3;
                    dstp[t * 128] = (tq * 8 + t < nb) ? silu_f(acc) : 0.f; r0 = r1; r1 = r2; r2 = r3; } }
        }
        if (wv == 0) { float g = 0.f, beta = 0.f;
            if (lane < nb) { const float bb = bf2f(ba[lane * 2]), aa = bf2f(ba[lane * 2 + 1]) + dtb; const float sp = aa > 20.f ? aa : log1pf(__expf(aa)); g = nalog * sp; beta = 1.0f / (1.0f + __expf(-bb)); }
            float gc = g;
#pragma unroll
            for (int o = 1; o < 32; o <<= 1) { const float t = __shfl_up(gc, o); if (lane >= o) gc += t; }
            if (lane < 32) *(LAS f32x4*)(gbk + lane * 4) = (f32x4){g, beta, gc, __expf(gc)}; }
        __syncthreads();
        {   const float GcLast = gbk[31 * 4 + 2];
            f32x2 q[4], k[4]; float sq[4], sk[4];
#pragma unroll
            for (int u = 0; u < 4; ++u) { const int tok = wv + 8 * u; q[u] = *(LAS f32x2*)(qf + tok * 128 + lane * 2); k[u] = *(LAS f32x2*)(kf + tok * 128 + lane * 2);
                sq[u] = q[u].x * q[u].x + q[u].y * q[u].y; sk[u] = k[u].x * k[u].x + k[u].y * k[u].y; }
#pragma unroll
            for (int u = 0; u < 4; ++u) { sq[u] = wave_sum(sq[u]); sk[u] = wave_sum(sk[u]); }
#pragma unroll
            for (int u = 0; u < 4; ++u) { const int tok = wv + 8 * u;
                const float rq = __builtin_amdgcn_rsqf(sq[u] + EPS) * 0.08838834764831845f, rk = __builtin_amdgcn_rsqf(sk[u] + EPS);
                const f32x2 qn = q[u] * rq, kn = k[u] * rk;
                *(LAS unsigned*)(Qb + tok * PK + lane * 2) = cvt_pk_bf16(qn.x, qn.y); *(LAS unsigned*)(Kb + tok * PK + lane * 2) = cvt_pk_bf16(kn.x, kn.y);
                const float dk = __expf(GcLast - gbk[tok * 4 + 2]); const unsigned kd = cvt_pk_bf16(kn.x * dk, kn.y * dk);
                KdT[(2 * lane) * PT + tok] = (bf16_t)(kd & 0xffffu); KdT[(2 * lane + 1) * PT + tok] = (bf16_t)(kd >> 16); }
#pragma unroll
            for (int dm = 0; dm < 8; ++dm) { u32x2 w; w.x = cvt_pk_bf16(Sacc[dm][0], Sacc[dm][1]); w.y = cvt_pk_bf16(Sacc[dm][2], Sacc[dm][3]);
                *(LAS u32x2*)(S0T + (16 * wv + fr) * PK + 16 * dm + 4 * fq) = w; }
        }
        __syncthreads();
        f32x4 accO[2];
        {   f32x4 acc1[4];
#pragma unroll
            for (int mi = 0; mi < 4; ++mi) acc1[mi] = (f32x4){0.f, 0.f, 0.f, 0.f};
#pragma unroll
            for (int ks = 0; ks < 4; ++ks) { const bf16x8 Y = *(const LAS bf16x8*)(S0T + (16 * wv + fr) * PK + 32 * ks + 8 * fq);
#pragma unroll
                for (int mi = 0; mi < 4; ++mi) { const bf16x8 X = *(const LAS bf16x8*)((mi < 2 ? Kb : Qb) + (16 * (mi & 1) + fr) * PK + 32 * ks + 8 * fq); acc1[mi] = MFMA16(X, Y, acc1[mi]); } }
            f32x4 acc2 = (f32x4){0.f, 0.f, 0.f, 0.f};
            {   const LAS bf16_t* Xb = (wv < 4 ? Kb : Qb) + (16 * ((wv >> 1) & 1) + fr) * PK; const LAS bf16_t* Yb = Kb + (16 * (wv & 1) + fr) * PK;
#pragma unroll
                for (int ks = 0; ks < 4; ++ks) acc2 = MFMA16(*(const LAS bf16x8*)(Xb + 32 * ks + 8 * fq), *(const LAS bf16x8*)(Yb + 32 * ks + 8 * fq), acc2); }
            {   const int ib = 16 * ((wv >> 1) & 1) + 4 * fq, jc = 16 * (wv & 1) + fr; const float Gj = gbk[jc * 4 + 2];
#pragma unroll
                for (int r = 0; r < 4; ++r) { const int i = ib + r; const f32x4 gi = *(const LAS f32x4*)(gbk + i * 4);
                    if (wv < 4) Am[i * 32 + jc] = (jc < i) ? gi[1] * __expf(gi[2] - Gj) * acc2[r] : 0.f;
                    else { const float pv = (jc <= i) ? __expf(gi[2] - Gj) * acc2[r] : 0.f; Pb[i * PT + jc] = (bf16_t)(cvt_pk_bf16(pv, 0.f) & 0xffffu); } } }
#pragma unroll
            for (int mi = 0; mi < 2; ++mi)
#pragma unroll
                for (int r = 0; r < 4; ++r) { const int i = 16 * mi + 4 * fq + r, e = 16 * wv + fr; const f32x4 gi = *(const LAS f32x4*)(gbk + i * 4);
                    Rf[i * 128 + e] = gi[1] * (Vf[i * 128 + e] - gi[3] * acc1[mi][r]); accO[mi][r] = gi[3] * acc1[2 + mi][r]; }
        }
        __syncthreads();
        if (tid < 128) { float dl[32];
            LAS float* Amo = Am; const LAS float* Rfo = Rf + tid; asm volatile("" : "+v"(Amo), "+v"(Rfo));
            f32x4 an[8]; float rn = Rfo[0];
#pragma unroll
            for (int i = 0; i < 32; ++i) { f32x4 ac[8]; float acc = rn;
#pragma unroll
                for (int j4 = 0; j4 < (i + 3) / 4; ++j4) ac[j4] = an[j4];
                if (i < 31) { rn = Rfo[(i + 1) * 128];
#pragma unroll
                    for (int j4 = 0; j4 < (i + 4) / 4; ++j4) an[j4] = *(const LAS f32x4*)(Amo + (i + 1) * 32 + 4 * j4); }
#pragma unroll
                for (int j4 = 0; j4 < (i + 3) / 4; ++j4)
#pragma unroll
                    for (int jj = 0; jj < 4; ++jj) if (4 * j4 + jj < i) acc -= ac[j4][jj] * dl[4 * j4 + jj];
                asm volatile("" : "+v"(acc) :: "memory"); dl[i] = acc; }
#pragma unroll
            for (int q8 = 0; q8 < 4; ++q8) { u32x4 w; w.x = cvt_pk_bf16(dl[8 * q8], dl[8 * q8 + 1]); w.y = cvt_pk_bf16(dl[8 * q8 + 2], dl[8 * q8 + 3]); w.z = cvt_pk_bf16(dl[8 * q8 + 4], dl[8 * q8 + 5]); w.w = cvt_pk_bf16(dl[8 * q8 + 6], dl[8 * q8 + 7]);
                *(LAS u32x4*)(DT + tid * PT + 8 * q8) = w; } }
        __syncthreads();
        {   const bf16x8 Y = *(const LAS bf16x8*)(DT + (16 * wv + fr) * PT + 8 * fq);
#pragma unroll
            for (int mi = 0; mi < 2; ++mi) { const bf16x8 X = *(const LAS bf16x8*)(Pb + (16 * mi + fr) * PT + 8 * fq); accO[mi] = MFMA16(X, Y, accO[mi]);
#pragma unroll
                for (int r = 0; r < 4; ++r) Of[(16 * mi + 4 * fq + r) * 128 + 16 * wv + fr] = accO[mi][r]; }
            const float aL = gbk[31 * 4 + 3];
#pragma unroll
            for (int dm = 0; dm < 8; ++dm) { const bf16x8 X = *(const LAS bf16x8*)(KdT + (16 * dm + fr) * PT + 8 * fq); Sacc[dm] = MFMA16(X, Y, Sacc[dm] * aL); }
        }
        __syncthreads();
        {   f32x2 o[4]; float ss[4];
#pragma unroll
            for (int u = 0; u < 4; ++u) { o[u] = *(const LAS f32x2*)(Of + (wv + 8 * u) * 128 + lane * 2); ss[u] = o[u].x * o[u].x + o[u].y * o[u].y; }
#pragma unroll
            for (int u = 0; u < 4; ++u) ss[u] = wave_sum(ss[u]);
#pragma unroll
            for (int u = 0; u < 4; ++u) { const int tok = wv + 8 * u;
                if (tok < nb) { const float r = __builtin_amdgcn_rsqf(ss[u] * (1.0f / 128.f) + EPS); const unsigned zz = *(const LAS unsigned*)(zr + tok * 128 + lane * 2);
                    *(unsigned*)(OG + (size_t)(row0 + t0 + tok) * VAL_DIM + hv * 128 + lane * 2) = cvt_pk_bf16(o[u].x * r * nw.x * silu_f(bflo(zz)), o[u].y * r * nw.y * silu_f(bfhi(zz))); } }
        }
        __syncthreads();
    }
    {   const int lane = tid0 & 63, wv = tid0 >> 6, fr = lane & 15, fq = lane >> 4;
        float* sd = (isPrompt ? P.out + O_DELTAP + ((size_t)(j * NB + b) * HV + hv) * 16384 : P.out + O_DELTAS + ((size_t)(j * DB + b) * HV + hv) * 16384) + 16 * wv + fr;
#pragma unroll
        for (int dm = 0; dm < 8; ++dm)
#pragma unroll
            for (int r = 0; r < 4; ++r) sd[(16 * dm + 4 * fq + r) * 128] = Sacc[dm][r]; }
}
__device__ __forceinline__ void delta_phase(LAS unsigned char* L, const Params& P, int j) {
    const int G = gridDim.x, bid = blockIdx.x;
    const bf16_t* proj = (const bf16_t*)(P.ws + WS_PROJ);
    {
        const size_t gtid = (size_t)bid * NTHREADS + opaque_tid(), gsz = (size_t)G * NTHREADS;
        for (size_t it = gtid; it < (size_t)NB * 3 * CONV_DIM; it += gsz) { const int b = (int)(it / (3 * CONV_DIM)), r = (int)(it % (3 * CONV_DIM)), p = r / CONV_DIM, c = r % CONV_DIM;
            P.out[O_CONVP + (size_t)j * NB * 3 * CONV_DIM + it] = bf2f(proj[(size_t)(b * SEQ + SEQ - 3 + p) * IN_PAD + c]); }
        for (size_t it = gtid; it < (size_t)DB * 3 * CONV_DIM; it += gsz) { const int b = (int)(it / (3 * CONV_DIM)), r = (int)(it % (3 * CONV_DIM)), p = r / CONV_DIM, c = r % CONV_DIM;
            P.out[O_CONVS + (size_t)j * DB * 3 * CONV_DIM + it] = bf2f(proj[(size_t)(TP + b * DS + 1 + p) * IN_PAD + c]); }
    }
    const int nP = NB * HV, nS = DB * HV;
#pragma unroll 1
    for (int k = 0;; ++k) {
        int it;
        if (G >= 2 * nP) { if (bid < nP) { if (k > 0) break; it = bid; } else it = nP + (bid - nP) + k * (G - nP); }
        else it = bid + k * G;
        if (it >= nP + nS) break;
        const bool isPrompt = it < nP; const int ii = isPrompt ? it : it - nP;
        delta_item(L, P, j, isPrompt, ii / HV, ii % HV);
    }
}

#define XB_TMO      128
#define XB_XCNT(j)  (256  + 64 * (j))
#define XB_XSUB(j)  (1280 + 64 * (j))
#define XB_XGEN(j)  (2304 + 64 * (j))
#define XB_TOP      3328
#define XB_TOPGEN   3392
#define XCD_BAR_WORDS 3456
#define XB_SPIN_CAP (1u << 22)
constexpr int LDS_ST_OFF = LDS_BYTES - 64;
__device__ __forceinline__ unsigned xb_ld(unsigned* p)              { return __hip_atomic_load(p, __ATOMIC_RELAXED, __HIP_MEMORY_SCOPE_AGENT); }
__device__ __forceinline__ unsigned xb_add(unsigned* p, unsigned v) { return __hip_atomic_fetch_add(p, v, __ATOMIC_RELAXED, __HIP_MEMORY_SCOPE_AGENT); }
__device__ __forceinline__ unsigned xb_xcc_id() { return (unsigned)__builtin_amdgcn_s_getreg((3 << 11) | 20) & 0xFu; }
#define XB_SPIN(cond, bar) do { unsigned _sp = 0; while (cond) { __builtin_amdgcn_s_sleep(1); \
    if ((++_sp & 255u) == 0u) { if (xb_ld(&(bar)[XB_TMO])) break; if (_sp > XB_SPIN_CAP) { atomicAdd(&(bar)[XB_TMO], 1u); break; } } } } while (0)
__device__ __forceinline__ void xcd_barrier_complete(unsigned* bar, unsigned x, unsigned& nloc, unsigned& nx) {
    const unsigned G = gridDim.x;
    unsigned sum, cnt, mine, sp = 0u;
    for (;;) {
        sum = 0u; cnt = 0u; mine = 0u;
#pragma unroll
        for (unsigned j = 0; j < 16; ++j) { const unsigned c = xb_ld(&bar[XB_XCNT(j)]); sum += c; cnt += (c > 0u) ? 1u : 0u; mine = (j == x) ? c : mine; }
        if (sum == G) break;
        __builtin_amdgcn_s_sleep(1);
        if ((++sp & 255u) == 0u) { if (xb_ld(&bar[XB_TMO])) break; if (sp > XB_SPIN_CAP) { atomicAdd(&bar[XB_TMO], 1u); break; } }
    }
    nloc = mine > 0u ? mine : 1u; nx = cnt > 0u ? cnt : 1u;
}
__device__ __forceinline__ void xcd_barrier(unsigned* bar, volatile LAS unsigned* st) {
    asm volatile("s_waitcnt vmcnt(0)" ::: "memory");
    __syncthreads();
    if (threadIdx.x == 0) {
        const unsigned x = xb_xcc_id();
        __builtin_amdgcn_s_waitcnt(0);
        unsigned nloc = st[0], nx = st[1];
        if (nloc == 0u) { xcd_barrier_complete(bar, x, nloc, nx); st[0] = nloc; st[1] = nx; }
        const unsigned old = xb_add(&bar[XB_XSUB(x)], 1u);
        const unsigned gen = old / nloc;
        if (old + 1u == (gen + 1u) * nloc) {
            __builtin_amdgcn_fence(__ATOMIC_RELEASE, "agent");
            asm volatile("s_waitcnt vmcnt(0)" ::: "memory");
            const unsigned og = xb_add(&bar[XB_TOP], 1u);
            const unsigned tg = og / nx;
            if (og + 1u == (tg + 1u) * nx) xb_add(&bar[XB_TOPGEN], 1u);
            else XB_SPIN(xb_ld(&bar[XB_TOPGEN]) == tg, bar);
            __builtin_amdgcn_fence(__ATOMIC_ACQUIRE, "agent");
            xb_add(&bar[XB_XGEN(x)], 1u);
            asm volatile("s_waitcnt vmcnt(0)" ::: "memory");
        } else {
            XB_SPIN(xb_ld(&bar[XB_XGEN(x)]) == gen, bar);
            __builtin_amdgcn_fence(__ATOMIC_ACQUIRE, "agent");
            asm volatile("s_waitcnt vmcnt(0)" ::: "memory");
        }
    }
    __syncthreads();
}

typedef const __attribute__((address_space(4))) Params* KP;
__device__ __forceinline__ Params ldp(KP kp) {
    asm volatile("" : "+s"(kp));
    Params P;
    P.x_prompt = kp->x_prompt; P.x_sample = kp->x_sample; P.state_pool = kp->state_pool; P.state_conv = kp->state_conv; P.state_delta = kp->state_delta; P.norm_gains = kp->norm_gains;
    P.w_gate = kp->w_gate; P.w_up = kp->w_up; P.w_down = kp->w_down; P.pool_w = kp->pool_w; P.pool_scale = kp->pool_scale; P.dn_w_in = kp->dn_w_in; P.dn_conv_w = kp->dn_conv_w;
    P.dn_a_log = kp->dn_a_log; P.dn_dt_bias = kp->dn_dt_bias; P.dn_norm_w = kp->dn_norm_w; P.dn_w_out = kp->dn_w_out; P.out = kp->out; P.ws = kp->ws;
    return P;
}
__global__ void __launch_bounds__(NTHREADS, 2) mk_fwd(Params Punused) {
    extern __shared__ __attribute__((aligned(16))) unsigned char lds_raw[];
    LAS unsigned char* lds = (LAS unsigned char*)lds_raw;
    cg::grid_group grid = cg::this_grid();
    KP kp = (KP)__builtin_amdgcn_kernarg_segment_ptr();

    {   const Params P = ldp(kp); unsigned* bar = (unsigned*)(P.ws + WS_BAR);
        if (blockIdx.x == 0) for (int i = threadIdx.x; i < XCD_BAR_WORDS; i += NTHREADS) bar[i] = 0u;
        if (threadIdx.x == 0) { ((volatile LAS unsigned*)(lds + LDS_ST_OFF))[0] = 0u; ((volatile LAS unsigned*)(lds + LDS_ST_OFF))[1] = 0u; } }
    { const Params P = ldp(kp); convert_weights((LAS float*)lds, P); }
    { const Params P = ldp(kp); row_pass(P, 0, 0.f, nullptr, P.norm_gains, -1, 1); }
    grid.sync();
    if (threadIdx.x == 0) { const Params P = ldp(kp); (void)xb_add(&((unsigned*)(P.ws + WS_BAR))[XB_XCNT(xb_xcc_id())], 1u); }
#define GBAR() do { const Params Pb = ldp(kp); xcd_barrier((unsigned*)(Pb.ws + WS_BAR), (volatile LAS unsigned*)(lds + LDS_ST_OFF)); } while (0)

#pragma unroll 1
    for (int step = 0; step < 12; ++step) {
        const int layer = step / 3, sub = step % 3, jm = layer >> 1;
        if (sub != 1) {
            const Params P = ldp(kp); const int l = layer * 2 + (sub >> 1);
            pg8::Gemm g{(const bf16_t*)(P.ws + WS_HN), (const bf16_t*)(P.ws + WS_WGU + l * SZ_WGU), D, D, D, 0}; pg8::StaticOrder S; S.init(T, 2 * FF, D, gridDim.x, blockIdx.x);
            pg8::EpiSwiGLU E{(bf16_t*)(P.ws + WS_H), FF}; pg8::gemm_phase(lds, g, S, E);
        } else if ((layer & 1) == 0) {
            const Params P = ldp(kp); pool_pass(P, jm);
        } else {
            {   const Params P = ldp(kp);
                pg8::Gemm g{(const bf16_t*)(P.ws + WS_HN), (const bf16_t*)(P.ws + WS_WIN + jm * SZ_WIN), D, D, D, 0}; pg8::StaticOrder S; S.init(T, IN_PAD, D, gridDim.x, blockIdx.x);
                pg8::EpiBf16 E{(bf16_t*)(P.ws + WS_PROJ), IN_PAD}; pg8::gemm_phase(lds, g, S, E); }
            GBAR();
            { const Params P = ldp(kp); delta_phase(lds, P, jm); }
        }
        GBAR();
        {   const Params P = ldp(kp);
            pg8::Gemm gf; const float* fscale = nullptr; const bf16_t* A = (const bf16_t*)(P.ws + WS_H); int nsplit;
            if (sub != 1) { const int l = layer * 2 + (sub >> 1); gf = pg8::Gemm{A, (const bf16_t*)(P.ws + WS_WDN + l * SZ_WDN), FF, FF, FF, 0}; nsplit = 11; }
            else if ((layer & 1) == 0) { gf = pg8::Gemm{A, (const bf16_t*)(P.ws + WS_WPOOL + jm * SZ_WPOOL), 256, D, 256, 256}; fscale = P.pool_scale + jm * D; nsplit = 1; }
            else { gf = pg8::Gemm{A, (const bf16_t*)(P.ws + WS_WOUT + jm * SZ_WOUT), VAL_DIM, VAL_DIM, VAL_DIM, 0}; nsplit = 8; }
            pg8::FinalOrder S; S.init(gf.K, nsplit, gridDim.x, blockIdx.x); pg8::EpiF32 E{(float*)(P.ws + WS_Y), fscale}; pg8::gemm_phase(lds, gf, S, E); }
        GBAR();
        {   const Params P = ldp(kp); const float* ng = P.norm_gains + (size_t)layer * 6 * D;
            const float* gpost = ng + (sub == 0 ? 1 : sub == 1 ? 3 : 5) * D;
            const float* gnext = sub == 0 ? ng + 2 * D : sub == 1 ? ng + 4 * D : (layer < 3 ? ng + 6 * D : nullptr);
            row_pass(P, 1, sub == 1 ? 1.0f : 0.5f, gpost, gnext, (sub == 0 && (layer & 1) == 0) ? jm : -1, sub != 1 ? 11 : ((layer & 1) == 0 ? 1 : 8)); }
        if (step < 11) GBAR();
    }
}

extern "C" void kernel_launch(void* const* d_in, const int* in_sizes, int n_in, void* d_out, int out_size, void* d_ws, size_t ws_size, hipStream_t stream) {
    static int grid = 0;
    if (grid == 0) {
        int dev = 0, cus = 0, per_cu = 0;
        if (ws_size < WS_END || n_in != 17) { fprintf(stderr, "kernel_launch: need %zu bytes of workspace (got %zu), 17 inputs (got %d)\n", (size_t)WS_END, ws_size, n_in); grid = -1; return; }
        if (hipGetDevice(&dev) != hipSuccess || hipDeviceGetAttribute(&cus, hipDeviceAttributeMultiprocessorCount, dev) != hipSuccess) { grid = -1; return; }
        if (hipFuncSetAttribute((const void*)mk_fwd, hipFuncAttributeMaxDynamicSharedMemorySize, LDS_BYTES) != hipSuccess) { fprintf(stderr, "hipFuncSetAttribute failed\n"); grid = -1; return; }
        if (hipOccupancyMaxActiveBlocksPerMultiprocessor(&per_cu, (const void*)mk_fwd, NTHREADS, LDS_BYTES) != hipSuccess || per_cu < 1) { fprintf(stderr, "occupancy query: %d\n", per_cu); }
        (void)hipGetLastError();
        grid = cus;
    }
    if (grid < 0) return;
    Params p{};
    p.x_prompt = (const float*)d_in[0]; p.x_sample = (const float*)d_in[1]; p.state_pool = (const float*)d_in[2]; p.state_conv = (const float*)d_in[3]; p.state_delta = (const float*)d_in[4];
    p.norm_gains = (const float*)d_in[5]; p.w_gate = (const float*)d_in[6]; p.w_up = (const float*)d_in[7]; p.w_down = (const float*)d_in[8]; p.pool_w = (const float*)d_in[9];
    p.pool_scale = (const float*)d_in[10]; p.dn_w_in = (const float*)d_in[11]; p.dn_conv_w = (const float*)d_in[12]; p.dn_a_log = (const float*)d_in[13]; p.dn_dt_bias = (const float*)d_in[14];
    p.dn_norm_w = (const float*)d_in[15]; p.dn_w_out = (const float*)d_in[16];
    p.out = (float*)d_out; p.ws = (unsigned char*)d_ws;
    void* args[] = {&p};
    hipError_t e = hipLaunchCooperativeKernel((const void*)mk_fwd, dim3(grid), dim3(NTHREADS), args, LDS_BYTES, stream);
    if (e != hipSuccess) fprintf(stderr, "cooperative launch failed: %s (grid %d)\n", hipGetErrorString(e), grid);
}
```
